# Optimizing an MI355X kernel written in HIP

```python
import functools
import jax, jax.numpy as jnp
from jax import lax
import numpy as np

D_MODEL = 2048
BATCH = 4
SEQ = 2048
DEPTH = 1
DEC_BATCH = 16
DEC_SEQ = 16
PAST_LEN = 4096

CHUNK = 64
LEFT_CHUNKS = 8
PAST_BAND = LEFT_CHUNKS * CHUNK
BAND = PAST_BAND + CHUNK
HEAD_DIM = 64
ATT_HEADS = D_MODEL // 128
ATT_WIDTH = ATT_HEADS * HEAD_DIM
RWKV_HEADS = D_MODEL // 128
RWKV_WIDTH = RWKV_HEADS * HEAD_DIM
DECAY_LORA = 96
ICLR_LORA = 96
GATE_LORA = 256
SHIFT_WIDTH = 3 * RWKV_WIDTH + DECAY_LORA + ICLR_LORA + GATE_LORA
PROJ_WIDTH = 3 * ATT_WIDTH + SHIFT_WIDTH + 2 * D_MODEL
SPLIT_IN = (ATT_WIDTH, 2 * ATT_WIDTH, 3 * ATT_WIDTH, 3 * ATT_WIDTH + SHIFT_WIDTH,
            3 * ATT_WIDTH + SHIFT_WIDTH + D_MODEL)
SPLIT_RWKV = (RWKV_WIDTH, 2 * RWKV_WIDTH, 3 * RWKV_WIDTH, 3 * RWKV_WIDTH + DECAY_LORA,
              3 * RWKV_WIDTH + DECAY_LORA + ICLR_LORA)
D_FF = 5632
MAX_REL = 128
RMS_EPS = 1e-6
GN_EPS = 64e-5
NEG_INF = -1e30

kernel_name = 'streaming_band_attn_rwkv7_macaron'


def rmsnorm(x, g):
    xf = x.astype(jnp.float32)
    y = xf * lax.rsqrt(jnp.mean(xf * xf, axis=-1, keepdims=True) + RMS_EPS)
    return (y * g.astype(jnp.float32)).astype(x.dtype)


def swiglu(x, w_in, w_down):
    gate, up = jnp.split(x @ w_in, 2, axis=-1)
    return (jax.nn.silu(gate) * up) @ w_down


def macaron_ffn(x, g_pre, g_post, w_in, w_down):
    return x + 0.5 * rmsnorm(swiglu(rmsnorm(x, g_pre), w_in, w_down), g_post)


def rel_bias_lookup(rel_bias, rel):
    return rel_bias[:, jnp.clip(rel, -MAX_REL, MAX_REL) + MAX_REL]


def softmax_attention(q, k, v, bias, mask):
    s = jnp.einsum('...qhd,...khd->...hqk', q, k).astype(jnp.float32) * (HEAD_DIM ** -0.5)
    s = s + bias.astype(jnp.float32)
    if mask is not None:
        s = jnp.where(mask, s, NEG_INF)
    p = jax.nn.softmax(s, axis=-1).astype(v.dtype)
    return jnp.einsum('...hqk,...khd->...qhd', p, v)


def band_attention_prompt(q, k, v, rel_bias):
    B, S, H, Dh = q.shape
    n_chunks = S // CHUNK
    qc = q.reshape(B, n_chunks, CHUNK, H, Dh)
    pad = ((0, 0), (PAST_BAND, 0), (0, 0), (0, 0))
    kc = jnp.pad(k, pad).reshape(B, n_chunks + LEFT_CHUNKS, CHUNK, H, Dh)
    vc = jnp.pad(v, pad).reshape(B, n_chunks + LEFT_CHUNKS, CHUNK, H, Dh)
    band_idx = jnp.arange(n_chunks)[:, None] + jnp.arange(LEFT_CHUNKS + 1)[None, :]
    kb = kc[:, band_idx].reshape(B, n_chunks, BAND, H, Dh)
    vb = vc[:, band_idx].reshape(B, n_chunks, BAND, H, Dh)
    rel = jnp.arange(CHUNK)[:, None] + PAST_BAND - jnp.arange(BAND)[None, :]
    bias = rel_bias_lookup(rel_bias, rel)
    key_pos = (jnp.arange(n_chunks)[:, None] - LEFT_CHUNKS) * CHUNK + jnp.arange(BAND)[None, :]
    mask = (key_pos >= 0)[:, None, None, :]
    return softmax_attention(qc, kb, vb, bias, mask).reshape(B, S, H, Dh)


def band_attention_sample(q, k, v, cache_k, cache_v, rel_bias):
    T = q.shape[1]
    n_past = cache_k.shape[1]
    kk = jnp.concatenate([cache_k.astype(k.dtype), k], axis=1)
    vv = jnp.concatenate([cache_v.astype(v.dtype), v], axis=1)
    rel = jnp.arange(T)[:, None] + n_past - jnp.arange(n_past + T)[None, :]
    bias = rel_bias_lookup(rel_bias, rel)
    return softmax_attention(q, kk, vv, bias, None)


def rwkv7_time_mix(p, prev_row, wkv0, mu, w0, w_up, a0, a_up, g_up, k_k, k_a, r_k, ln_w, ln_b):
    B, T, _ = p.shape
    dt = p.dtype
    f32 = jnp.float32
    prev = jnp.concatenate([prev_row.astype(dt), p[:, :-1]], axis=1)
    xm = p + (prev - p) * mu
    r, k, v, wd, ad, gd = jnp.split(xm, SPLIT_RWKV, axis=-1)
    w_log = -jax.nn.softplus(-(w0 + jnp.tanh(wd) @ w_up).astype(f32)) - 0.5
    decay = jnp.exp(-jnp.exp(w_log))
    a = jax.nn.sigmoid((a0 + ad @ a_up).astype(f32))
    g = jax.nn.sigmoid(gd) @ g_up

    def heads(t):
        return t.astype(f32).reshape(B, T, RWKV_HEADS, HEAD_DIM)

    kk = heads(k * k_k)
    kk = kk / jnp.maximum(jnp.sqrt(jnp.sum(kk * kk, axis=-1, keepdims=True)), 1e-12)
    k = k.astype(f32) * (1.0 + (a - 1.0) * k_a)
    r_h, k_h, v_h, a_h, w_h = heads(r), heads(k), heads(v), heads(a), heads(decay)

    def step(S, inp):
        r_t, w_t, k_t, v_t, kk_t, a_t = inp
        sa = jnp.einsum('bhvk,bhk->bhv', S, -kk_t)
        S = (S * w_t[:, :, None, :] + sa[:, :, :, None] * (kk_t * a_t)[:, :, None, :]
             + v_t[:, :, :, None] * k_t[:, :, None, :])
        return S, jnp.einsum('bhvk,bhk->bhv', S, r_t)

    xs = tuple(jnp.moveaxis(t, 1, 0) for t in (r_h, w_h, k_h, v_h, kk, a_h))
    S_final, ys = lax.scan(step, wkv0.astype(f32), xs)
    y = jnp.moveaxis(ys, 0, 1)
    mean = jnp.mean(y, axis=-1, keepdims=True)
    var = jnp.mean(jnp.square(y - mean), axis=-1, keepdims=True)
    y = ((y - mean) * lax.rsqrt(var + GN_EPS)).reshape(B, T, RWKV_WIDTH) * ln_w + ln_b
    bonus = jnp.sum(r_h * k_h * r_k, axis=-1, keepdims=True) * v_h
    y = y + bonus.reshape(B, T, RWKV_WIDTH)
    return (y * g).astype(dt), S_final.astype(wkv0.dtype), p[:, -1:]


def trunk_layer(x, attend, prev_row, wkv0, norm_ffn1_pre, norm_ffn1_post, w_ffn1_in, w_ffn1_down,
                norm_mix_pre, norm_mix_post, w_in, w_att_out, rwkv_mu, rwkv_w0, rwkv_w_up, rwkv_a0,
                rwkv_a_up, rwkv_g_up, rwkv_k_k, rwkv_k_a, rwkv_r_k, rwkv_ln_w, rwkv_ln_b, w_rwkv_out,
                w_out, norm_ffn2_pre, norm_ffn2_post, w_ffn2_in, w_ffn2_down):
    B, T, _ = x.shape
    x = macaron_ffn(x, norm_ffn1_pre, norm_ffn1_post, w_ffn1_in, w_ffn1_down)
    h = rmsnorm(x, norm_mix_pre)
    q, k, v, pb, gate_a, gate_b = jnp.split(h @ w_in, SPLIT_IN, axis=-1)
    q = q.reshape(B, T, ATT_HEADS, HEAD_DIM)
    k = k.reshape(B, T, ATT_HEADS, HEAD_DIM)
    v = v.reshape(B, T, ATT_HEADS, HEAD_DIM)
    att = attend(q, k, v).reshape(B, T, ATT_WIDTH) @ w_att_out
    rw, wkv, shift_row = rwkv7_time_mix(pb, prev_row, wkv0, rwkv_mu, rwkv_w0, rwkv_w_up, rwkv_a0,
                                        rwkv_a_up, rwkv_g_up, rwkv_k_k, rwkv_k_a, rwkv_r_k,
                                        rwkv_ln_w, rwkv_ln_b)
    rw = rw @ w_rwkv_out
    mixed = (jax.nn.sigmoid(gate_a) * att + jax.nn.sigmoid(gate_b) * rw) @ w_out
    x = x + rmsnorm(mixed, norm_mix_post)
    x = macaron_ffn(x, norm_ffn2_pre, norm_ffn2_post, w_ffn2_in, w_ffn2_down)
    return x, k, v, wkv, shift_row


def setup_inputs(seed: int = 0) -> dict:
    key = jax.random.key(seed)
    ks = jax.random.split(key, 32)
    f32 = jnp.float32
    L = DEPTH
    att_past = min(PAST_BAND, PAST_LEN)

    def nrm(i, shape, scale=1.0):
        return scale * jax.random.normal(ks[i], shape, f32)

    def gain(i, shape, center=1.0):
        return center + 0.05 * jax.random.normal(ks[i], shape, f32)

    return {
        'x_prompt': nrm(0, (BATCH, SEQ, D_MODEL)),
        'x_sample': nrm(1, (DEC_BATCH, DEC_SEQ, D_MODEL)),
        'cache_k': nrm(2, (L, DEC_BATCH, att_past, ATT_HEADS, HEAD_DIM)),
        'cache_v': nrm(3, (L, DEC_BATCH, att_past, ATT_HEADS, HEAD_DIM)),
        'state_wkv': nrm(4, (L, DEC_BATCH, RWKV_HEADS, HEAD_DIM, HEAD_DIM), 0.5),
        'state_shift': nrm(5, (L, DEC_BATCH, 1, SHIFT_WIDTH)),
        'norm_ffn1_pre': gain(6, (L, D_MODEL)),
        'norm_ffn1_post': gain(7, (L, D_MODEL)),
        'w_ffn1_in': nrm(8, (L, D_MODEL, 2 * D_FF), D_MODEL ** -0.5),
        'w_ffn1_down': nrm(9, (L, D_FF, D_MODEL), D_FF ** -0.5),
        'norm_mix_pre': gain(10, (L, D_MODEL)),
        'norm_mix_post': gain(11, (L, D_MODEL)),
        'w_in': nrm(12, (L, D_MODEL, PROJ_WIDTH), D_MODEL ** -0.5),
        'rel_bias': nrm(13, (L, ATT_HEADS, 2 * MAX_REL + 1), 0.5),
        'w_att_out': nrm(14, (L, ATT_WIDTH, D_MODEL), ATT_WIDTH ** -0.5),
        'rwkv_mu': jax.random.uniform(ks[15], (L, SHIFT_WIDTH), f32, 0.0, 1.0),
        'rwkv_w0': jax.random.uniform(ks[16], (L, RWKV_WIDTH), f32, -6.0, -1.0),
        'rwkv_w_up': nrm(17, (L, DECAY_LORA, RWKV_WIDTH), 0.5 * DECAY_LORA ** -0.5),
        'rwkv_a0': nrm(18, (L, RWKV_WIDTH), 0.1),
        'rwkv_a_up': nrm(19, (L, ICLR_LORA, RWKV_WIDTH), 0.5 * ICLR_LORA ** -0.5),
        'rwkv_g_up': nrm(20, (L, GATE_LORA, RWKV_WIDTH), GATE_LORA ** -0.5),
        'rwkv_k_k': gain(21, (L, RWKV_WIDTH), 0.85),
        'rwkv_k_a': gain(22, (L, RWKV_WIDTH)),
        'rwkv_r_k': nrm(23, (L, RWKV_HEADS, HEAD_DIM), 0.1),
        'rwkv_ln_w': gain(24, (L, RWKV_WIDTH)),
        'rwkv_ln_b': nrm(25, (L, RWKV_WIDTH), 0.02),
        'w_rwkv_out': nrm(26, (L, RWKV_WIDTH, D_MODEL), RWKV_WIDTH ** -0.5),
        'w_out': nrm(27, (L, D_MODEL, D_MODEL), D_MODEL ** -0.5),
        'norm_ffn2_pre': gain(28, (L, D_MODEL)),
        'norm_ffn2_post': gain(29, (L, D_MODEL)),
        'w_ffn2_in': nrm(30, (L, D_MODEL, 2 * D_FF), D_MODEL ** -0.5),
        'w_ffn2_down': nrm(31, (L, D_FF, D_MODEL), D_FF ** -0.5),
    }


def reference(x_prompt, x_sample, cache_k, cache_v, state_wkv, state_shift,
              norm_ffn1_pre, norm_ffn1_post, w_ffn1_in, w_ffn1_down,
              norm_mix_pre, norm_mix_post, w_in, rel_bias, w_att_out,
              rwkv_mu, rwkv_w0, rwkv_w_up, rwkv_a0, rwkv_a_up, rwkv_g_up,
              rwkv_k_k, rwkv_k_a, rwkv_r_k, rwkv_ln_w, rwkv_ln_b, w_rwkv_out, w_out,
              norm_ffn2_pre, norm_ffn2_post, w_ffn2_in, w_ffn2_down):
    B = x_prompt.shape[0]
    keep_rows = min(PAST_BAND, x_prompt.shape[1])
    y_p, y_s = x_prompt, x_sample
    kp_l, vp_l, wp_l, sp_l = [], [], [], []
    ks_l, vs_l, ws_l, ss_l = [], [], [], []
    for l in range(DEPTH):
        layer = functools.partial(
            trunk_layer,
            norm_ffn1_pre=norm_ffn1_pre[l], norm_ffn1_post=norm_ffn1_post[l],
            w_ffn1_in=w_ffn1_in[l], w_ffn1_down=w_ffn1_down[l],
            norm_mix_pre=norm_mix_pre[l], norm_mix_post=norm_mix_post[l],
            w_in=w_in[l], w_att_out=w_att_out[l],
            rwkv_mu=rwkv_mu[l], rwkv_w0=rwkv_w0[l], rwkv_w_up=rwkv_w_up[l], rwkv_a0=rwkv_a0[l],
            rwkv_a_up=rwkv_a_up[l], rwkv_g_up=rwkv_g_up[l], rwkv_k_k=rwkv_k_k[l],
            rwkv_k_a=rwkv_k_a[l], rwkv_r_k=rwkv_r_k[l], rwkv_ln_w=rwkv_ln_w[l],
            rwkv_ln_b=rwkv_ln_b[l], w_rwkv_out=w_rwkv_out[l], w_out=w_out[l],
            norm_ffn2_pre=norm_ffn2_pre[l], norm_ffn2_post=norm_ffn2_post[l],
            w_ffn2_in=w_ffn2_in[l], w_ffn2_down=w_ffn2_down[l])
        attend_p = functools.partial(band_attention_prompt, rel_bias=rel_bias[l])
        shift0 = jnp.zeros((B, 1, SHIFT_WIDTH), x_prompt.dtype)
        wkv0 = jnp.zeros((B, RWKV_HEADS, HEAD_DIM, HEAD_DIM), state_wkv.dtype)
        y_p, k_p, v_p, wkv_p, sh_p = layer(y_p, attend_p, shift0, wkv0)
        kp_l.append(k_p[:, -keep_rows:])
        vp_l.append(v_p[:, -keep_rows:])
        wp_l.append(wkv_p)
        sp_l.append(sh_p)
        attend_s = functools.partial(band_attention_sample, cache_k=cache_k[l], cache_v=cache_v[l],
                                     rel_bias=rel_bias[l])
        y_s, k_s, v_s, wkv_s, sh_s = layer(y_s, attend_s, state_shift[l], state_wkv[l])
        ks_l.append(k_s)
        vs_l.append(v_s)
        ws_l.append(wkv_s)
        ss_l.append(sh_s)
    new_k_prompt = jnp.stack(kp_l)
    new_v_prompt = jnp.stack(vp_l)
    new_wkv_prompt = jnp.stack(wp_l)
    new_shift_prompt = jnp.stack(sp_l)
    new_k_sample = jnp.stack(ks_l)
    new_v_sample = jnp.stack(vs_l)
    new_wkv_sample = jnp.stack(ws_l)
    new_shift_sample = jnp.stack(ss_l)
    return (y_p, y_s, new_k_prompt, new_v_prompt, new_wkv_prompt, new_shift_prompt,
            new_k_sample, new_v_sample, new_wkv_sample, new_shift_sample)
```

```cpp
#include <hip/hip_runtime.h>
#include <hip/hip_cooperative_groups.h>
#include <cstdio>
#include <cstdint>
namespace cg = cooperative_groups;

#define LAS __attribute__((address_space(3)))
typedef unsigned short bf16_t;
typedef short bf16x8 __attribute__((ext_vector_type(8)));
typedef float f32x4 __attribute__((ext_vector_type(4)));
typedef unsigned u32x4 __attribute__((ext_vector_type(4)));
typedef unsigned u32x2 __attribute__((ext_vector_type(2)));
typedef float f32x2 __attribute__((ext_vector_type(2)));

constexpr int D = 2048, MP = 8192, MS = 256, M = MP + MS, FF = 5632, NIN = 10688, NINP = 10752, SW = 3520, HW = 1024;
constexpr int SEQ = 2048, NB = 4, DB = 16, DT = 16, NPAST = 512, KCAT = NPAST + DT  , VTS = 576;
constexpr float RMS_EPS = 1e-6f, GN_EPS = 64e-5f;

constexpr size_t O_Y = 0, O_KP = (size_t)M * D, O_VP = O_KP + 2097152, O_WKVP = O_VP + 2097152, O_SHP = O_WKVP + 262144, O_KS = O_SHP + 14080,
                 O_VS = O_KS + 262144, O_WKVS = O_VS + 262144, O_SHS = O_WKVS + 1048576;

constexpr size_t SZ_H = (size_t)M * D * 2;
constexpr size_t SZ_Q = (size_t)M * HW * 2;
constexpr size_t SZ_F1 = (size_t)M * HW * 4;
constexpr size_t WS_WA = 0;
constexpr size_t WS_WB = WS_WA + (size_t)11264 * 2048 * 2;
constexpr size_t WS_WATT = WS_WB + (size_t)2048 * 5632 * 2;
constexpr size_t WS_WRW = WS_WATT + (size_t)2048 * 1024 * 2;
constexpr size_t WS_WOUT = WS_WRW + (size_t)2048 * 1024 * 2;
constexpr size_t WS_WL = WS_WOUT + (size_t)2048 * 2048 * 2;
constexpr size_t WS_E = WS_WL + (size_t)3072 * 512 * 2;
constexpr size_t WS_FG = WS_E + SZ_H;
constexpr size_t SZ_ACT = (size_t)M * FF * 2;
constexpr size_t WS_Y = WS_FG + SZ_ACT;
constexpr size_t SZ_FG = SZ_ACT + (size_t)M * D * 4;
constexpr size_t WS_PB = WS_FG;
constexpr size_t WS_QB = WS_FG + SZ_FG - 2 * SZ_Q;
constexpr size_t WS_KB = WS_QB + SZ_Q;
constexpr size_t WS_W = WS_FG;
constexpr size_t WS_A = WS_W + SZ_F1;
constexpr size_t WS_G = WS_A + SZ_F1;
constexpr size_t WS_YR = WS_G + SZ_Q;
constexpr size_t WS_VT = WS_FG + SZ_FG;
constexpr size_t WS_KC = WS_VT + (size_t)NB * 16 * 64 * SEQ * 2;
constexpr size_t WS_VS = WS_KC + (size_t)(DB * KCAT + 64) * HW * 2;
constexpr size_t WS_RKV = WS_VS + (size_t)DB * 16 * 64 * VTS * 2;
constexpr size_t WS_GT = WS_RKV + 3 * SZ_F1;
constexpr size_t WS_BAR = WS_GT + (size_t)M * 4096 * 2;
constexpr size_t WS_END = WS_BAR + 16384;
static_assert(WS_YR + SZ_F1 <= WS_QB, "overlay");
static_assert(WS_PB + (size_t)M * SW * 4 <= WS_QB, "overlay");

constexpr int LDS_BYTES = 152 * 1024;

struct Params { const float* in[32]; float* out; unsigned char* ws; int ph_lo, ph_hi; };

__device__ __forceinline__ unsigned pk2(float lo, float hi) { unsigned r; asm volatile("v_cvt_pk_bf16_f32 %0, %1, %2" : "=v"(r) : "v"(lo), "v"(hi)); return r; }
__device__ __forceinline__ float bf2f(unsigned short b) { return __uint_as_float(((unsigned)b) << 16); }
__device__ __forceinline__ float wave_sum(float v) {
#pragma unroll
    for (int o = 1; o < 64; o <<= 1) v += __shfl_xor(v, o);
    return v;
}
#define DPP_ADD(v, ctrl) ((v) + __builtin_bit_cast(float, __builtin_amdgcn_update_dpp(0, __builtin_bit_cast(int, (v)), (ctrl), 0xf, 0xf, true)))
__device__ __forceinline__ float row16_sum(float v) {
    v = DPP_ADD(v, 0xB1); v = DPP_ADD(v, 0x4E); v = DPP_ADD(v, 0x141); v = DPP_ADD(v, 0x128); return v;
}
__device__ __forceinline__ float sigmoidf_(float x) { return 1.f / (1.f + __expf(-x)); }
#define LDS_WAIT() asm volatile("s_waitcnt lgkmcnt(0)" ::: "memory")
__device__ __forceinline__ float fma_s(float a, float b, float c) { float r; asm("v_fma_f32 %0, %1, %2, %3" : "=v"(r) : "v"(a), "v"(b), "v"(c)); return r; }
__device__ __forceinline__ float mul_s(float a, float b) { float r; asm("v_mul_f32 %0, %1, %2" : "=v"(r) : "v"(a), "v"(b)); return r; }
__device__ __forceinline__ float add_s(float a, float b) { float r; asm("v_add_f32 %0, %1, %2" : "=v"(r) : "v"(a), "v"(b)); return r; }

#define XB_TMO      128
#define XB_XCNT(j)  (256  + 64 * (j))
#define XB_XSUB(j)  (1280 + 64 * (j))
#define XB_XGEN(j)  (2304 + 64 * (j))
#define XB_TOP      3328
#define XB_TOPGEN   3392
#define XCD_BAR_WORDS 3456
#define XB_SPIN_CAP (1u << 18)
__device__ __forceinline__ unsigned xb_ld(unsigned* p)              { return __hip_atomic_load(p, __ATOMIC_RELAXED, __HIP_MEMORY_SCOPE_AGENT); }
__device__ __forceinline__ unsigned xb_add(unsigned* p, unsigned v) { return __hip_atomic_fetch_add(p, v, __ATOMIC_RELAXED, __HIP_MEMORY_SCOPE_AGENT); }
__device__ __forceinline__ unsigned xb_xcc_id() { return (unsigned)__builtin_amdgcn_s_getreg((3 << 11) | 20) & 0xFu; }
#define XB_SPIN(cond, bar) do { unsigned _sp = 0; while (cond) { __builtin_amdgcn_s_sleep(1); \
    if ((++_sp & 255u) == 0u) { if (xb_ld(&(bar)[XB_TMO])) break; if (_sp > XB_SPIN_CAP) { atomicAdd(&(bar)[XB_TMO], 1u); break; } } } } while (0)
struct XcdBarrier { unsigned* bar; unsigned x; volatile LAS unsigned* st; };
__device__ __forceinline__ XcdBarrier xcd_barrier_post(unsigned* bar, volatile LAS unsigned* st) {
    XcdBarrier b; b.bar = bar; b.x = xb_xcc_id(); b.st = st;
    if (threadIdx.x == 0) (void)xb_add(&bar[XB_XCNT(b.x)], 1u);
    return b;
}
__device__ __forceinline__ void xcd_barrier_complete(unsigned* bar, unsigned x, unsigned& nloc, unsigned& nx) {
    const unsigned G = gridDim.x * gridDim.y * gridDim.z;
    unsigned sum, cnt, mine, sp = 0u;
    for (;;) {
        sum = 0u; cnt = 0u; mine = 0u;
#pragma unroll
        for (unsigned j = 0; j < 16; ++j) { const unsigned c = xb_ld(&bar[XB_XCNT(j)]); sum += c; cnt += (c > 0u) ? 1u : 0u; mine = (j == x) ? c : mine; }
        if (sum == G) break;
        __builtin_amdgcn_s_sleep(1);
        if ((++sp & 255u) == 0u) { if (xb_ld(&bar[XB_TMO])) break; if (sp > XB_SPIN_CAP) { atomicAdd(&bar[XB_TMO], 1u); break; } }
    }
    nloc = mine > 0u ? mine : 1u; nx = cnt > 0u ? cnt : 1u;
}
__device__ __forceinline__ void xcd_barrier(const XcdBarrier& b) {
    asm volatile("s_waitcnt vmcnt(0)" ::: "memory");
    __syncthreads();
    if (threadIdx.x == 0) {
        unsigned* bar = b.bar;
        __builtin_amdgcn_s_waitcnt(0);
        unsigned nloc = b.st[0], nx = b.st[1];
        if (nloc == 0u) { xcd_barrier_complete(bar, b.x, nloc, nx); b.st[0] = nloc; b.st[1] = nx; }
        const unsigned old = xb_add(&bar[XB_XSUB(b.x)], 1u);
        const unsigned gen = old / nloc;
        if (old + 1u == (gen + 1u) * nloc) {
            __builtin_amdgcn_fence(__ATOMIC_RELEASE, "agent");
            asm volatile("s_waitcnt vmcnt(0)" ::: "memory");
            const unsigned og = xb_add(&bar[XB_TOP], 1u);
            const unsigned tg = og / nx;
            if (og + 1u == (tg + 1u) * nx) xb_add(&bar[XB_TOPGEN], 1u);
            else XB_SPIN(xb_ld(&bar[XB_TOPGEN]) == tg, bar);
            __builtin_amdgcn_fence(__ATOMIC_ACQUIRE, "agent");
            xb_add(&bar[XB_XGEN(b.x)], 1u);
            asm volatile("s_waitcnt vmcnt(0)" ::: "memory");
        } else {
            XB_SPIN(xb_ld(&bar[XB_XGEN(b.x)]) == gen, bar);
            __builtin_amdgcn_fence(__ATOMIC_ACQUIRE, "agent");
            asm volatile("s_waitcnt vmcnt(0)" ::: "memory");
        }
    }
    __syncthreads();
}

namespace pg8 {
constexpr int BM = 256, BK = 64, HALF = 128, HTB = HALF * BK * 2, STAGE_BYTES = 8 * HTB, NXCD = 8, WGM = 8;
__device__ __forceinline__ int lds_byte(int r, int c) { const int st = (r >> 4) * 2 + (c >> 5), rr = r & 15, cc = c & 31, ob = rr * 64 + cc * 2; return st * 1024 + (ob ^ (((ob >> 9) & 1) << 5)); }
__device__ __forceinline__ void stage_rc(int b, int& R, int& C) { const int st = b / 1024, sb = b % 1024, swz = sb ^ (((sb >> 9) & 1) << 5); R = (st >> 1) * 16 + swz / 64; C = (st & 1) * 32 + (swz % 64) / 2; }
struct Unit { int pm, pn, k0, nt; };
struct Gemm { const bf16_t* A; const bf16_t* Bt; int M, N, K; };
struct StaticOrder {
    int nM, nN, nwg, G, c, ntk;
    __device__ __forceinline__ void init(int M_, int N_, int G_, int c_, int K_) { nM = M_ / BM; nN = N_ / BM; nwg = nM * nN; G = G_; c = c_; ntk = K_ / BK; }
    __device__ __forceinline__ bool next(int i, Unit& u) const {
        const long L = (long)i * G + c; if (L >= nwg) return false;
        int wgid = (int)L; { const int q = nwg / NXCD, r = nwg % NXCD, xcd = wgid % NXCD, off = wgid / NXCD; wgid = (xcd < r ? xcd * (q + 1) : r * (q + 1) + (xcd - r) * q) + off; }
        const int nig = WGM * nN, gid = wgid / nig, fm = gid * WGM, gsz = (nM - fm) < WGM ? (nM - fm) : WGM;
        u.pm = fm + ((wgid % nig) % gsz); u.pn = (wgid % nig) / gsz; u.k0 = 0; u.nt = ntk; return true;
    }
};
struct SplitOrder {
    int nN, nfull, nsplit, G, c, ntk;
    __device__ __forceinline__ void init(int, int N_, int G_, int c_, int K_) { nN = N_ / BM; nfull = 32 * nN; ntk = K_ / BK; nsplit = nN * (ntk / 4); G = G_; c = c_; }
    __device__ __forceinline__ bool next(int i, Unit& u) const {
        const int L = i * G + c;
        if (L < nfull) { int wgid = L; { const int q = nfull / NXCD, xcd = wgid % NXCD, off = wgid / NXCD; wgid = xcd * q + off; }
            const int nig = WGM * nN; const int gid = wgid / nig, fm = gid * WGM;
            u.pm = fm + ((wgid % nig) % WGM); u.pn = (wgid % nig) / WGM; u.k0 = 0; u.nt = ntk; return true; }
        const int r = L - nfull; if (r >= nsplit) return false;
        u.pm = 32; u.pn = r % nN; u.k0 = (r / nN) * 4; u.nt = 4; return true;
    }
};

template <class Epi, class Sched>
__device__ __forceinline__ void gemm_phase(LAS unsigned char* lds, const Gemm g, const Sched& S, const Epi& E) {
    const int tid = threadIdx.x, wid = __builtin_amdgcn_readfirstlane(tid >> 6), lane = tid & 63, wr = wid >> 2, wc = wid & 3, fr = lane & 15, fq = lane >> 4;
    const int K = g.K;
    unsigned voffA[2];
#pragma unroll
    for (int i = 0; i < 2; ++i) { int R, C; stage_rc(tid * 16 + i * 8192, R, C); voffA[i] = (unsigned)(R * K + C) * 2u; }
    const size_t kstep = (size_t)(BK * 2);
    const size_t hstep = (size_t)HALF * K * 2;
    const size_t tstep = 2 * hstep;
    const unsigned ldsw = (unsigned)wid * 1024u;
    const int aoff = lds_byte(wr * 64 + fr, fq * 8), boff = lds_byte(wc * 32 + fr, fq * 8);
#define PG8_SA(b, h) (((b) * 2 + (h)) * HTB)
#define PG8_SB(b, h) ((4 + (b) * 2 + (h)) * HTB)
#define PG8_STAGE(bufoff, gbase) do { _Pragma("unroll") for (int _i = 0; _i < 2; ++_i) \
        __builtin_amdgcn_global_load_lds((const unsigned*)((const char*)(gbase) + voffA[_i]), (LAS unsigned*)(lds + (bufoff) + ldsw + _i * 8192), 16, 0, 0); } while (0)
#define PG8_LDA(dst, b, h) do { _Pragma("unroll") for (int m = 0; m < 4; ++m) _Pragma("unroll") for (int k = 0; k < 2; ++k) dst[m][k] = *(const LAS bf16x8*)(lds + PG8_SA(b, h) + aoff + m * 2048 + k * 1024); } while (0)
#define PG8_LDB(dst, b, h) do { _Pragma("unroll") for (int n = 0; n < 2; ++n) _Pragma("unroll") for (int k = 0; k < 2; ++k) dst[n][k] = *(const LAS bf16x8*)(lds + PG8_SB(b, h) + boff + n * 2048 + k * 1024); } while (0)
#define PG8_MMA(ai, bj, At, Bt) do { __builtin_amdgcn_s_setprio(1); _Pragma("unroll") for (int m = 0; m < 4; ++m) _Pragma("unroll") for (int n = 0; n < 2; ++n) _Pragma("unroll") for (int k = 0; k < 2; ++k) \
        acc[ai][bj][m][n] = __builtin_amdgcn_mfma_f32_16x16x32_bf16(Bt[n][k], At[m][k], acc[ai][bj][m][n], 0, 0, 0); __builtin_amdgcn_s_setprio(0); } while (0)
#define PG8_WAIT_V(n) asm volatile("s_waitcnt vmcnt(" #n ")" ::: "memory")
#define PG8_WAIT_L(n) asm volatile("s_waitcnt lgkmcnt(" #n ")" ::: "memory")
#define PG8_BAR __builtin_amdgcn_s_barrier()
#define PG8_SCHED __builtin_amdgcn_sched_barrier(0)
    Unit cur, nxt; int ui = 0;
    if (!S.next(0, cur)) return;
    f32x4 acc[2][2][4][2];
#pragma unroll
    for (int a = 0; a < 2; ++a)
#pragma unroll
        for (int b = 0; b < 2; ++b)
#pragma unroll
            for (int m = 0; m < 4; ++m)
#pragma unroll
                for (int n = 0; n < 2; ++n) acc[a][b][m][n] = (f32x4){0.f, 0.f, 0.f, 0.f};
    bf16x8 At[4][2], B0[2][2], B1[2][2];
    const char* cA = (const char*)g.A + (size_t)cur.pm * tstep + (size_t)cur.k0 * kstep; const char* cB = (const char*)g.Bt + (size_t)cur.pn * tstep + (size_t)cur.k0 * kstep;
    PG8_STAGE(PG8_SB(0, 0), cB); PG8_STAGE(PG8_SB(0, 1), cB + hstep); PG8_STAGE(PG8_SA(0, 0), cA); PG8_STAGE(PG8_SA(0, 1), cA + hstep);
    if (wr == 1) PG8_BAR;
    PG8_WAIT_V(2); PG8_BAR;
    PG8_STAGE(PG8_SB(1, 0), cB + kstep); PG8_STAGE(PG8_SA(1, 0), cA + kstep); PG8_STAGE(PG8_SB(1, 1), cB + hstep + kstep);
    PG8_WAIT_V(6); PG8_BAR;
    for (;;) {
        const bool has_next = S.next(ui + 1, nxt);
        const char* nA = has_next ? (const char*)g.A + (size_t)nxt.pm * tstep + (size_t)nxt.k0 * kstep : cA; const char* nB = has_next ? (const char*)g.Bt + (size_t)nxt.pn * tstep + (size_t)nxt.k0 * kstep : cB;
        const int nt = cur.nt;
        for (int t = 0; t < nt; t += 2) {
            const bool last = (t == nt - 2);
            const char* a1 = cA + (size_t)(t + 1) * kstep;
            const char* a2 = last ? nA : cA + (size_t)(t + 2) * kstep; const char* b2 = last ? nB : cB + (size_t)(t + 2) * kstep;
            const char* a3 = a2 + kstep; const char* b3 = b2 + kstep;
            PG8_LDB(B0, 0, 0); PG8_LDB(B1, 0, 1); PG8_SCHED; PG8_LDA(At, 0, 0); PG8_STAGE(PG8_SA(1, 1), a1 + hstep);
            PG8_WAIT_V(8); PG8_WAIT_L(0); PG8_BAR; PG8_MMA(0, 0, At, B0); PG8_MMA(0, 1, At, B1); PG8_BAR; PG8_SCHED;
            PG8_LDA(At, 0, 1); PG8_STAGE(PG8_SB(0, 0), b2); PG8_STAGE(PG8_SB(0, 1), b2 + hstep); PG8_STAGE(PG8_SA(0, 0), a2);
            PG8_WAIT_V(8); PG8_WAIT_L(0); PG8_BAR; PG8_MMA(1, 0, At, B0); PG8_MMA(1, 1, At, B1); PG8_BAR; PG8_SCHED;
            PG8_LDB(B0, 1, 0); PG8_LDB(B1, 1, 1); PG8_SCHED; PG8_LDA(At, 1, 0); PG8_STAGE(PG8_SA(0, 1), a2 + hstep);
            PG8_WAIT_V(8); PG8_WAIT_L(0); PG8_BAR; PG8_MMA(0, 0, At, B0); PG8_MMA(0, 1, At, B1); PG8_BAR; PG8_SCHED;
            PG8_LDA(At, 1, 1); PG8_STAGE(PG8_SB(1, 0), b3); PG8_STAGE(PG8_SB(1, 1), b3 + hstep); PG8_STAGE(PG8_SA(1, 0), a3);
            PG8_WAIT_V(8); PG8_WAIT_L(0); PG8_BAR; PG8_MMA(1, 0, At, B0); PG8_MMA(1, 1, At, B1); PG8_BAR; PG8_SCHED;
        }
        if (wr == 0) PG8_BAR;
        E(acc, cur, wr, wc, fr, fq);
        if (!has_next) break;
#pragma unroll
        for (int a = 0; a < 2; ++a)
#pragma unroll
            for (int b = 0; b < 2; ++b)
#pragma unroll
                for (int m = 0; m < 4; ++m)
#pragma unroll
                    for (int n = 0; n < 2; ++n) acc[a][b][m][n] = (f32x4){0.f, 0.f, 0.f, 0.f};
        cur = nxt; cA = nA; cB = nB; ++ui;
        if (wr == 1) PG8_BAR;
    }
    PG8_WAIT_V(0);
    PG8_BAR;
#undef PG8_SA
#undef PG8_SB
#undef PG8_STAGE
#undef PG8_LDA
#undef PG8_LDB
#undef PG8_MMA
#undef PG8_WAIT_V
#undef PG8_WAIT_L
#undef PG8_BAR
#undef PG8_SCHED
}
}
using pg8::Unit;

#define EPI_ROW(ai, m) (u.pm * 256 + (ai) * 128 + wr * 64 + (m) * 16 + fr)
#define EPI_COL(bj, n) (u.pn * 256 + (bj) * 128 + wc * 32 + (n) * 16 + 4 * fq)

struct EpiF32 {
    float* C; int ldc; float* part;
    __device__ __forceinline__ void operator()(const f32x4 (&acc)[2][2][4][2], const Unit& u, int wr, int wc, int fr, int fq) const {
#pragma unroll
        for (int ai = 0; ai < 2; ++ai)
#pragma unroll
            for (int m = 0; m < 4; ++m) { float* rowp = (u.pm == 32 && part) ? part + ((size_t)(u.k0 >> 2) * MS + (EPI_ROW(ai, m) - MP)) * ldc : C + (size_t)EPI_ROW(ai, m) * ldc;
#pragma unroll
                for (int bj = 0; bj < 2; ++bj)
#pragma unroll
                    for (int n = 0; n < 2; ++n) { float* q = rowp + EPI_COL(bj, n); const f32x4 v = acc[ai][bj][m][n];
                        *(f32x4*)q = v; } }
    }
};
struct EpiSwiglu {
    bf16_t* O;
    __device__ __forceinline__ void operator()(const f32x4 (&acc)[2][2][4][2], const Unit& u, int wr, int wc, int fr, int fq) const {
#pragma unroll
        for (int ai = 0; ai < 2; ++ai)
#pragma unroll
            for (int m = 0; m < 4; ++m) { bf16_t* rowp = O + (size_t)EPI_ROW(ai, m) * FF + u.pn * 128 + wc * 32 + 4 * fq;
#pragma unroll
                for (int n = 0; n < 2; ++n) { const f32x4 g = acc[ai][0][m][n], up = acc[ai][1][m][n]; float o[4];
#pragma unroll
                    for (int i = 0; i < 4; ++i) o[i] = g[i] * up[i] / (1.f + __expf(-g[i]));
                    u32x2 w; w.x = pk2(o[0], o[1]); w.y = pk2(o[2], o[3]); *(u32x2*)(rowp + n * 16) = w; } }
    }
};
struct EpiWin {
    bf16_t *Q, *KB, *KC, *VT, *VS, *GT; float *PB, *out;
    __device__ __forceinline__ void operator()(const f32x4 (&acc)[2][2][4][2], const Unit& u, int wr, int wc, int fr, int fq) const {
#pragma unroll
        for (int ai = 0; ai < 2; ++ai)
#pragma unroll
            for (int m = 0; m < 4; ++m) { const int r = EPI_ROW(ai, m);
                const bool smp = r >= MP; const int b = smp ? ((r - MP) >> 4) : (r >> 11), t = smp ? ((r - MP) & 15) : (r & 2047);
#pragma unroll
                for (int bj = 0; bj < 2; ++bj)
#pragma unroll
                    for (int n = 0; n < 2; ++n) { const int c = EPI_COL(bj, n); const f32x4 v = acc[ai][bj][m][n];
                        if (c < 1024) { u32x2 w; w.x = pk2(v[0] * 0.125f, v[1] * 0.125f); w.y = pk2(v[2] * 0.125f, v[3] * 0.125f); *(u32x2*)(Q + (size_t)r * HW + c) = w; }
                        else if (c < 2048) { const int cc = c - 1024; u32x2 w; w.x = pk2(v[0], v[1]); w.y = pk2(v[2], v[3]);
                            if (smp) { *(u32x2*)(KC + ((size_t)b * KCAT + NPAST + t) * HW + cc) = w; *(f32x4*)(out + O_KS + ((size_t)b * DT + t) * HW + cc) = v; }
                            else { *(u32x2*)(KB + (size_t)r * HW + cc) = w; if (t >= SEQ - 512) *(f32x4*)(out + O_KP + ((size_t)b * 512 + (t - (SEQ - 512))) * HW + cc) = v; } }
                        else if (c < 3072) { const int cc = c - 2048, h = cc >> 6, d = cc & 63;
                            if (smp) { bf16_t* vp = VS + ((size_t)(b * 16 + h) * 64 + d) * VTS + NPAST + t;
#pragma unroll
                                for (int i = 0; i < 4; ++i) vp[(size_t)i * VTS] = (bf16_t)(pk2(v[i], 0.f) & 0xffffu);
                                *(f32x4*)(out + O_VS + ((size_t)b * DT + t) * HW + cc) = v; }
                            else { bf16_t* vp = VT + ((size_t)(b * 16 + h) * 64 + d) * SEQ + t;
#pragma unroll
                                for (int i = 0; i < 4; ++i) vp[(size_t)i * SEQ] = (bf16_t)(pk2(v[i], 0.f) & 0xffffu);
                                if (t >= SEQ - 512) *(f32x4*)(out + O_VP + ((size_t)b * 512 + (t - (SEQ - 512))) * HW + cc) = v; } }
                        else if (c < 3072 + SW) { *(f32x4*)(PB + (size_t)r * SW + (c - 3072)) = v; }
                        else if (c < NIN) { u32x2 w; w.x = pk2(sigmoidf_(v[0]), sigmoidf_(v[1])); w.y = pk2(sigmoidf_(v[2]), sigmoidf_(v[3])); *(u32x2*)(GT + (size_t)r * 4096 + (c - 3072 - SW)) = w; }
                    } }
    }
};
struct EpiLora {
    float *Wd, *Aa; bf16_t* Gg; const float *w0, *a0;
    __device__ __forceinline__ void operator()(const f32x4 (&acc)[2][2][4][2], const Unit& u, int wr, int wc, int fr, int fq) const {
#pragma unroll
        for (int ai = 0; ai < 2; ++ai)
#pragma unroll
            for (int m = 0; m < 4; ++m) { const int r = EPI_ROW(ai, m);
#pragma unroll
                for (int bj = 0; bj < 2; ++bj)
#pragma unroll
                    for (int n = 0; n < 2; ++n) { const int c = EPI_COL(bj, n); const f32x4 v = acc[ai][bj][m][n];
                        if (c < 1024) { const f32x4 z0 = *(const f32x4*)(w0 + c); f32x4 o;
#pragma unroll
                            for (int i = 0; i < 4; ++i) o[i] = __expf(-0.6065306597f * sigmoidf_(v[i] + z0[i]));
                            *(f32x4*)(Wd + (size_t)r * HW + c) = o; }
                        else if (c < 2048) { const int cc = c - 1024; const f32x4 z0 = *(const f32x4*)(a0 + cc); f32x4 o;
#pragma unroll
                            for (int i = 0; i < 4; ++i) o[i] = sigmoidf_(v[i] + z0[i]);
                            *(f32x4*)(Aa + (size_t)r * HW + cc) = o; }
                        else { const int cc = c - 2048; u32x2 w; w.x = pk2(v[0], v[1]); w.y = pk2(v[2], v[3]); *(u32x2*)(Gg + (size_t)r * HW + cc) = w; }
                    } }
    }
};
struct EpiGateA {
    float* T1; const bf16_t* GT; float* part;
    __device__ __forceinline__ void operator()(const f32x4 (&acc)[2][2][4][2], const Unit& u, int wr, int wc, int fr, int fq) const {
#pragma unroll
        for (int ai = 0; ai < 2; ++ai)
#pragma unroll
            for (int m = 0; m < 4; ++m) { const int r = EPI_ROW(ai, m);
#pragma unroll
                for (int bj = 0; bj < 2; ++bj)
#pragma unroll
                    for (int n = 0; n < 2; ++n) { const int c = EPI_COL(bj, n); const f32x4 v = acc[ai][bj][m][n];
                        const u32x2 gw = *(const u32x2*)(GT + (size_t)r * 4096 + c); f32x4 o;
                        o[0] = v[0] * __uint_as_float(gw.x << 16); o[1] = v[1] * __uint_as_float(gw.x & 0xffff0000u); o[2] = v[2] * __uint_as_float(gw.y << 16); o[3] = v[3] * __uint_as_float(gw.y & 0xffff0000u);
                        if (u.pm == 32) *(f32x4*)(part + ((size_t)(u.k0 >> 2) * MS + (r - MP)) * D + c) = o; else *(f32x4*)(T1 + (size_t)r * D + c) = o; } }
    }
};
struct EpiGateB {
    float* T1; const bf16_t* GT; bf16_t* MIX; float* part;
    __device__ __forceinline__ void operator()(const f32x4 (&acc)[2][2][4][2], const Unit& u, int wr, int wc, int fr, int fq) const {
#pragma unroll
        for (int ai = 0; ai < 2; ++ai)
#pragma unroll
            for (int m = 0; m < 4; ++m) { const int r = EPI_ROW(ai, m);
#pragma unroll
                for (int bj = 0; bj < 2; ++bj)
#pragma unroll
                    for (int n = 0; n < 2; ++n) { const int c = EPI_COL(bj, n); const f32x4 v = acc[ai][bj][m][n];
                        const u32x2 gw = *(const u32x2*)(GT + (size_t)r * 4096 + 2048 + c); f32x4 o;
                        if (u.pm == 32) { o[0] = v[0] * __uint_as_float(gw.x << 16); o[1] = v[1] * __uint_as_float(gw.x & 0xffff0000u); o[2] = v[2] * __uint_as_float(gw.y << 16); o[3] = v[3] * __uint_as_float(gw.y & 0xffff0000u);
                            *(f32x4*)(part + ((size_t)(u.k0 >> 2) * MS + (r - MP)) * D + c) = o; continue; }
                        const f32x4 t1 = *(const f32x4*)(T1 + (size_t)r * D + c);
                        o[0] = t1[0] + v[0] * __uint_as_float(gw.x << 16); o[1] = t1[1] + v[1] * __uint_as_float(gw.x & 0xffff0000u);
                        o[2] = t1[2] + v[2] * __uint_as_float(gw.y << 16); o[3] = t1[3] + v[3] * __uint_as_float(gw.y & 0xffff0000u);
                        u32x2 w; w.x = pk2(o[0], o[1]); w.y = pk2(o[2], o[3]); *(u32x2*)(MIX + (size_t)r * D + c) = w; } }
    }
};

struct TrJob { const float* W; bf16_t* WT; int K, N, item; int sw; };
__device__ __forceinline__ void tr_load(const TrJob& jb, int lane, float (&tv)[32]) {
    const int nblk = jb.N / 32, kb = jb.item / nblk, nb = jb.item - kb * nblk, k0 = 64 * kb, n0 = 32 * nb;
#pragma unroll
    for (int i = 0; i < 32; ++i) tv[i] = __builtin_nontemporal_load(jb.W + (size_t)(k0 + 2 * i + (lane >> 5)) * jb.N + n0 + (lane & 31));
}
__device__ __forceinline__ void tr_store(const TrJob& jb, int lane, const float (&tv)[32], LAS float* scr) {
    const int nblk = jb.N / 32, kb = jb.item / nblk, nb = jb.item - kb * nblk, k0 = 64 * kb, n0 = 32 * nb;
#pragma unroll
    for (int i = 0; i < 32; ++i) scr[(2 * i + (lane >> 5)) * 33 + (lane & 31)] = tv[i];
    LDS_WAIT();
    int d0 = n0;
    if (jb.sw) { const int bj = n0 / FF, j = n0 - bj * FF; d0 = 256 * (j >> 7) + 128 * bj + (j & 127); }
    const int c = lane & 7;
#pragma unroll
    for (int j = 0; j < 4; ++j) { const int n = (lane >> 3) + 8 * j; const LAS float* sp = scr + (8 * c) * 33 + n;
        u32x4 o; o.x = pk2(sp[0 * 33], sp[1 * 33]); o.y = pk2(sp[2 * 33], sp[3 * 33]); o.z = pk2(sp[4 * 33], sp[5 * 33]); o.w = pk2(sp[6 * 33], sp[7 * 33]);
        *(u32x4*)(jb.WT + (size_t)(d0 + n) * jb.K + k0 + 8 * c) = o; }
    LDS_WAIT();
}
#define TR_RUN(first, count, stride, RESOLVE) do { int it_ = (first); if (it_ < (count)) { TrJob ja_, jb_; float ta_[32], tb_[32]; RESOLVE(it_, ja_); tr_load(ja_, lane, ta_); \
        for (;;) { int nx_ = it_ + (stride); if (nx_ < (count)) { RESOLVE(nx_, jb_); tr_load(jb_, lane, tb_); } tr_store(ja_, lane, ta_, TR_SCR); if (nx_ >= (count)) break; it_ = nx_; \
                   nx_ = it_ + (stride); if (nx_ < (count)) { RESOLVE(nx_, ja_); tr_load(ja_, lane, ta_); } tr_store(jb_, lane, tb_, TR_SCR); if (nx_ >= (count)) break; it_ = nx_; } } } while (0)

__device__ __forceinline__ void resnorm_load(const float* xin, const float* Y, int lane, f32x4 (&y)[8], f32x4 (&x)[8]) {
#pragma unroll
    for (int j = 0; j < 8; ++j) { y[j] = ((const f32x4*)Y)[lane + 64 * j]; x[j] = __builtin_nontemporal_load((const f32x4*)xin + lane + 64 * j); }
}
__device__ __forceinline__ void resnorm_proc(f32x4 (&y)[8], const f32x4 (&x)[8], float scale, const float* gpost, const float* gnext, float* xout, bf16_t* hout, int lane) {
    float s = 0.f;
#pragma unroll
    for (int j = 0; j < 8; ++j) s += (y[j][0] * y[j][0] + y[j][1] * y[j][1]) + (y[j][2] * y[j][2] + y[j][3] * y[j][3]);
    const float rs = scale * rsqrtf(wave_sum(s) * (1.f / D) + RMS_EPS);
    float s2 = 0.f;
#pragma unroll
    for (int j = 0; j < 8; ++j) { const f32x4 g = ((const f32x4*)gpost)[lane + 64 * j];
        y[j] = x[j] + y[j] * g * rs; ((f32x4*)xout)[lane + 64 * j] = y[j];
        s2 += (y[j][0] * y[j][0] + y[j][1] * y[j][1]) + (y[j][2] * y[j][2] + y[j][3] * y[j][3]); }
    if (hout) { const float rs2 = rsqrtf(wave_sum(s2) * (1.f / D) + RMS_EPS);
#pragma unroll
        for (int j = 0; j < 8; ++j) { const f32x4 g = ((const f32x4*)gnext)[lane + 64 * j]; u32x2 w; w.x = pk2(y[j][0] * rs2 * g[0], y[j][1] * rs2 * g[1]); w.y = pk2(y[j][2] * rs2 * g[2], y[j][3] * rs2 * g[3]);
            ((u32x2*)hout)[lane + 64 * j] = w; } }
}
#define RESNORM_ROWS(XIN, SCALE, GPOST, GNEXT, HOUT) do { int r_ = gw; if (r_ < MP) { f32x4 ya_[8], xa_[8], yb_[8], xb_[8]; resnorm_load((XIN) + (size_t)r_ * D, Y + (size_t)r_ * D, lane, ya_, xa_); \
        for (;;) { int n_ = r_ + NGW; if (n_ < MP) resnorm_load((XIN) + (size_t)n_ * D, Y + (size_t)n_ * D, lane, yb_, xb_); \
                   resnorm_proc(ya_, xa_, (SCALE), (GPOST), (GNEXT), X1 + (size_t)r_ * D, (HOUT) ? (HOUT) + (size_t)r_ * D : nullptr, lane); if (n_ >= MP) break; r_ = n_; \
                   n_ = r_ + NGW; if (n_ < MP) resnorm_load((XIN) + (size_t)n_ * D, Y + (size_t)n_ * D, lane, ya_, xa_); \
                   resnorm_proc(yb_, xb_, (SCALE), (GPOST), (GNEXT), X1 + (size_t)r_ * D, (HOUT) ? (HOUT) + (size_t)r_ * D : nullptr, lane); if (n_ >= MP) break; r_ = n_; } } } while (0)

__device__ __forceinline__ float block_sum(float v, LAS float* red, int wave) {
    v = wave_sum(v); __syncthreads(); if ((threadIdx.x & 63) == 0) red[wave] = v; __syncthreads();
    return ((red[0] + red[1]) + (red[2] + red[3])) + ((red[4] + red[5]) + (red[6] + red[7]));
}
__device__ __forceinline__ void resnorm_row_block(const float* xin, const float* P0, int nparts, float scale, const float* gpost, const float* gnext, float* xout, bf16_t* hout, LAS float* red, int wave) {
    const int t = threadIdx.x; f32x4 y = (f32x4){0.f, 0.f, 0.f, 0.f};
#pragma unroll 11
    for (int q = 0; q < nparts; ++q) y += ((const f32x4*)(P0 + (size_t)q * MS * D))[t];
    const float rs = scale * rsqrtf(block_sum((y[0] * y[0] + y[1] * y[1]) + (y[2] * y[2] + y[3] * y[3]), red, wave) * (1.f / D) + RMS_EPS);
    const f32x4 x = ((const f32x4*)xin)[t], g = ((const f32x4*)gpost)[t];
    y = x + y * g * rs; ((f32x4*)xout)[t] = y;
    if (hout) { const float rs2 = rsqrtf(block_sum((y[0] * y[0] + y[1] * y[1]) + (y[2] * y[2] + y[3] * y[3]), red, wave) * (1.f / D) + RMS_EPS);
        const f32x4 gn = ((const f32x4*)gnext)[t]; u32x2 w; w.x = pk2(y[0] * rs2 * gn[0], y[1] * rs2 * gn[1]); w.y = pk2(y[2] * rs2 * gn[2], y[3] * rs2 * gn[3]); ((u32x2*)hout)[t] = w; }
}

__device__ __forceinline__ void attn_unit(const bf16_t* Qp, const bf16_t* Kp, const bf16_t* Vt, int vstride, int key_lo, int ntiles, int key_hi, int q_abs0,
                                          const LAS float* bias, bf16_t* Op, int lane) {
    const int fr = lane & 15, fq = lane >> 4;
    bf16x8 qf[2];
#pragma unroll
    for (int ks = 0; ks < 2; ++ks) qf[ks] = *(const bf16x8*)(Qp + (size_t)fr * HW + fq * 8 + 32 * ks);
    float m_run = -1e30f, l_run = 0.f;
    f32x4 o[4];
#pragma unroll
    for (int db = 0; db < 4; ++db) o[db] = (f32x4){0.f, 0.f, 0.f, 0.f};
    const int qa = q_abs0 + fr;
#define ATT_LOAD(KF, VLO, VHI, K0) do { \
        _Pragma("unroll") for (int nb = 0; nb < 4; ++nb) _Pragma("unroll") for (int ks = 0; ks < 2; ++ks) KF[nb][ks] = *(const bf16x8*)(Kp + (size_t)((K0) + 16 * nb + fr) * HW + fq * 8 + 32 * ks); \
        _Pragma("unroll") for (int db = 0; db < 4; ++db) _Pragma("unroll") for (int ks = 0; ks < 2; ++ks) { const bf16_t* vp = Vt + (size_t)(16 * db + fr) * vstride + (K0) + 32 * ks + 4 * fq; \
            VLO[db][ks] = *(const u32x2*)vp; VHI[db][ks] = *(const u32x2*)(vp + 16); } } while (0)
    bf16x8 kf[4][2]; u32x2 vlo[4][2], vhi[4][2];
    ATT_LOAD(kf, vlo, vhi, key_lo);
#pragma unroll 1
    for (int tile = 0; tile < ntiles; ++tile) {
        const int key0 = key_lo + 64 * tile;
        const int keyn = key0 + (tile + 1 < ntiles ? 64 : 0);
        bf16x8 kfn[4][2]; u32x2 vlon[4][2], vhin[4][2];
        ATT_LOAD(kfn, vlon, vhin, keyn);
        f32x4 s[4];
#pragma unroll
        for (int nb = 0; nb < 4; ++nb) { s[nb] = (f32x4){0.f, 0.f, 0.f, 0.f};
#pragma unroll
            for (int ks = 0; ks < 2; ++ks) s[nb] = __builtin_amdgcn_mfma_f32_16x16x32_bf16(kf[nb][ks], qf[ks], s[nb], 0, 0, 0); }
        float mx = -1e30f;
        if (q_abs0 - (key0 + 63) >= 128 && key0 + 64 <= key_hi) {
            const float bfar = bias[256];
#pragma unroll
            for (int nb = 0; nb < 4; ++nb)
#pragma unroll
                for (int j = 0; j < 4; ++j) { const float v = s[nb][j] + bfar; s[nb][j] = v; mx = fmaxf(mx, v); }
        } else {
#pragma unroll
            for (int nb = 0; nb < 4; ++nb)
#pragma unroll
                for (int j = 0; j < 4; ++j) { const int key = key0 + 16 * nb + 4 * fq + j; int rel = qa - key; rel = rel < -128 ? -128 : (rel > 128 ? 128 : rel);
                    float v = s[nb][j] + bias[rel + 128]; v = key < key_hi ? v : -1e30f; s[nb][j] = v; mx = fmaxf(mx, v); }
        }
        mx = fmaxf(mx, __shfl_xor(mx, 16)); mx = fmaxf(mx, __shfl_xor(mx, 32));
        const float m_new = fmaxf(m_run, mx), alpha = __expf(m_run - m_new);
        float ps = 0.f;
#pragma unroll
        for (int nb = 0; nb < 4; ++nb)
#pragma unroll
            for (int j = 0; j < 4; ++j) { const float p = __expf(s[nb][j] - m_new); s[nb][j] = p; ps += p; }
        l_run = l_run * alpha + ps; m_run = m_new;
#pragma unroll
        for (int db = 0; db < 4; ++db) o[db] *= alpha;
#pragma unroll
        for (int ks = 0; ks < 2; ++ks) { u32x4 pw; pw.x = pk2(s[2 * ks][0], s[2 * ks][1]); pw.y = pk2(s[2 * ks][2], s[2 * ks][3]); pw.z = pk2(s[2 * ks + 1][0], s[2 * ks + 1][1]); pw.w = pk2(s[2 * ks + 1][2], s[2 * ks + 1][3]);
            const bf16x8 pf = __builtin_bit_cast(bf16x8, pw);
#pragma unroll
            for (int db = 0; db < 4; ++db) { u32x4 vw; vw.x = vlo[db][ks].x; vw.y = vlo[db][ks].y; vw.z = vhi[db][ks].x; vw.w = vhi[db][ks].y;
                o[db] = __builtin_amdgcn_mfma_f32_16x16x32_bf16(__builtin_bit_cast(bf16x8, vw), pf, o[db], 0, 0, 0); } }
#pragma unroll
        for (int a = 0; a < 4; ++a)
#pragma unroll
            for (int b = 0; b < 2; ++b) { kf[a][b] = kfn[a][b]; vlo[a][b] = vlon[a][b]; vhi[a][b] = vhin[a][b]; }
    }
#undef ATT_LOAD
    l_run += __shfl_xor(l_run, 16); l_run += __shfl_xor(l_run, 32);
    const float inv = 1.f / l_run;
#pragma unroll
    for (int db = 0; db < 4; ++db) { u32x2 w; w.x = pk2(o[db][0] * inv, o[db][1] * inv); w.y = pk2(o[db][2] * inv, o[db][3] * inv); *(u32x2*)(Op + (size_t)fr * HW + 16 * db + 4 * fq) = w; }
}

constexpr int TC = 32;
constexpr int CH_FLOATS = 6 * TC * 64;
__device__ __forceinline__ void scan_signal(LAS unsigned* cnt, int lane) {
    LDS_WAIT();
    if (lane == 0) __hip_atomic_fetch_add(cnt, 1u, __ATOMIC_RELAXED, __HIP_MEMORY_SCOPE_WORKGROUP);
}
__device__ __forceinline__ void scan_wait(LAS unsigned* cnt, unsigned target) {
    while (__hip_atomic_load(cnt, __ATOMIC_RELAXED, __HIP_MEMORY_SCOPE_WORKGROUP) < target) __builtin_amdgcn_s_sleep(1);
    asm volatile("" ::: "memory");
}
__device__ __forceinline__ void scan_unit4(LAS float* lds, LAS unsigned* cnt, unsigned& base, const float* R, const float* Kk, const float* V, const float* Wd, const float* Aa,
                                           int row0, int T, int h, int quarter, const float* S0, float* Sout, float* Yraw, const float* k_k, const float* k_a) {
    const int tid = threadIdx.x, lane = tid & 63, wave = tid >> 6;
    const int ts = tid >> 4, f4 = tid & 15;
    const int rg = lane >> 4, j = lane & 15, row = quarter * 16 + wave * 4 + rg;
    const f32x4 kk4 = *(const f32x4*)(k_k + h * 64 + 4 * f4), ka4 = *(const f32x4*)(k_a + h * 64 + 4 * f4);
    f32x4 S = S0 ? *(const f32x4*)(S0 + row * 64 + 4 * j) : (f32x4){0.f, 0.f, 0.f, 0.f};
    const int nch = (T + TC - 1) / TC;
    f32x4 gr[2], gw[2], gk[2], gv[2], ga[2];
#define SCAN_LOAD(c) do { _Pragma("unroll") for (int q_ = 0; q_ < 2; ++q_) { const int t_ = (c) * TC + ts + 16 * q_; if (t_ < T) { const size_t o_ = (size_t)(row0 + t_) * HW + h * 64 + 4 * f4; \
        gr[q_] = *(const f32x4*)(R + o_); gw[q_] = *(const f32x4*)(Wd + o_); gk[q_] = *(const f32x4*)(Kk + o_); gv[q_] = *(const f32x4*)(V + o_); ga[q_] = *(const f32x4*)(Aa + o_); } \
        else { gr[q_] = gw[q_] = gk[q_] = gv[q_] = ga[q_] = (f32x4){0.f, 0.f, 0.f, 0.f}; } } } while (0)
#define SCAN_STORE(c) do { _Pragma("unroll") for (int q_ = 0; q_ < 2; ++q_) { LAS float* b_ = lds + ((c) & 1) * CH_FLOATS + (ts + 16 * q_) * 64 + 4 * f4; \
        const f32x4 kx = gk[q_] * kk4; float ss = (kx[0] * kx[0] + kx[1] * kx[1]) + (kx[2] * kx[2] + kx[3] * kx[3]); ss = row16_sum(ss); \
        const float inv = -__builtin_amdgcn_rsqf(fmaxf(ss, 1e-24f)); const f32x4 nkk = kx * inv; \
        *(LAS f32x4*)(b_) = gr[q_]; *(LAS f32x4*)(b_ + TC * 64) = gw[q_]; *(LAS f32x4*)(b_ + 2 * TC * 64) = gk[q_] * (1.f + (ga[q_] - 1.f) * ka4); \
        *(LAS f32x4*)(b_ + 3 * TC * 64) = nkk; *(LAS f32x4*)(b_ + 4 * TC * 64) = -nkk * ga[q_]; \
        LAS float* v_ = lds + ((c) & 1) * CH_FLOATS + 5 * TC * 64 + (4 * f4) * TC + ts + 16 * q_; v_[0] = gv[q_][0]; v_[TC] = gv[q_][1]; v_[2 * TC] = gv[q_][2]; v_[3 * TC] = gv[q_][3]; } } while (0)
    SCAN_LOAD(0); SCAN_STORE(0); scan_signal(cnt, lane);
    for (int c = 0; c < nch; ++c) {
        if (c + 1 < nch) SCAN_LOAD(c + 1);
        scan_wait(cnt, 4u * (base + (unsigned)c + 1u));
        const LAS float* buf = lds + (c & 1) * CH_FLOATS;
        const int nst = (T - c * TC) < TC ? (T - c * TC) : TC;
        const LAS float* bt = buf + 4 * j; const LAS float* bv = buf + 5 * TC * 64 + row * TC;
        f32x4 r4 = *(const LAS f32x4*)(bt), w4 = *(const LAS f32x4*)(bt + TC * 64), kp4 = *(const LAS f32x4*)(bt + 2 * TC * 64),
              nk4 = *(const LAS f32x4*)(bt + 3 * TC * 64), ka_4 = *(const LAS f32x4*)(bt + 4 * TC * 64);
        f32x4 r4b = *(const LAS f32x4*)(bt + 64), w4b = *(const LAS f32x4*)(bt + 64 + TC * 64), kp4b = *(const LAS f32x4*)(bt + 64 + 2 * TC * 64),
              nk4b = *(const LAS f32x4*)(bt + 64 + 3 * TC * 64), ka_4b = *(const LAS f32x4*)(bt + 64 + 4 * TC * 64);
        for (int t0 = 0; t0 < nst; t0 += 16) {
            float vv16[16];
#pragma unroll
            for (int i = 0; i < 4; ++i) { const f32x4 t_ = *(const LAS f32x4*)(bv + t0 + 4 * i); vv16[4 * i] = t_[0]; vv16[4 * i + 1] = t_[1]; vv16[4 * i + 2] = t_[2]; vv16[4 * i + 3] = t_[3]; }
            float yp[16];
            f32x4 rprev = r4;
#pragma unroll
            for (int tt = 0; tt < 16; ++tt) {
                const LAS float* bn = bt + (t0 + tt + 2) * 64;
                const f32x4 r4n = *(const LAS f32x4*)(bn), w4n = *(const LAS f32x4*)(bn + TC * 64), kp4n = *(const LAS f32x4*)(bn + 2 * TC * 64),
                            nk4n = *(const LAS f32x4*)(bn + 3 * TC * 64), ka_4n = *(const LAS f32x4*)(bn + 4 * TC * 64);
                f32x2 d2 = (f32x2){S[0], S[1]} * (f32x2){nk4[0], nk4[1]};
                f32x2 e2 = (f32x2){S[0], S[1]} * (f32x2){rprev[0], rprev[1]};
                d2 = __builtin_elementwise_fma((f32x2){S[2], S[3]}, (f32x2){nk4[2], nk4[3]}, d2);
                e2 = __builtin_elementwise_fma((f32x2){S[2], S[3]}, (f32x2){rprev[2], rprev[3]}, e2);
                float sa = d2[0] + d2[1];
                if (tt > 0) yp[tt - 1] = e2[0] + e2[1];
                sa = row16_sum(sa);
                S = S * w4 + ka_4 * sa + kp4 * vv16[tt];
                rprev = r4;
                r4 = r4b; w4 = w4b; kp4 = kp4b; nk4 = nk4b; ka_4 = ka_4b;
                r4b = r4n; w4b = w4n; kp4b = kp4n; nk4b = nk4n; ka_4b = ka_4n;
            }
            { f32x2 e2 = (f32x2){S[0], S[1]} * (f32x2){rprev[0], rprev[1]}; e2 = __builtin_elementwise_fma((f32x2){S[2], S[3]}, (f32x2){rprev[2], rprev[3]}, e2); yp[15] = e2[0] + e2[1]; }
            float ykeep;
            { const bool b3 = (j & 8) != 0, b2 = (j & 4) != 0, b1 = (j & 2) != 0, b0 = (j & 1) != 0;
#define DPP_GET(v, ctrl) __builtin_bit_cast(float, __builtin_amdgcn_update_dpp(0, __builtin_bit_cast(int, (v)), (ctrl), 0xf, 0xf, true))
              float q8[8], q4[4], q2[2];
#pragma unroll
              for (int i = 0; i < 8; ++i) { const float keep = b3 ? yp[8 + i] : yp[i], send = b3 ? yp[i] : yp[8 + i]; q8[i] = keep + DPP_GET(send, 0x128); }
#pragma unroll
              for (int i = 0; i < 4; ++i) { const float keep = b2 ? q8[4 + i] : q8[i], send = b2 ? q8[i] : q8[4 + i]; q4[i] = keep + DPP_GET(send, 0x141); }
#pragma unroll
              for (int i = 0; i < 2; ++i) { const float keep = b1 ? q4[2 + i] : q4[i], send = b1 ? q4[i] : q4[2 + i]; q2[i] = keep + DPP_GET(send, 0x4E); }
              { const float keep = b0 ? q2[1] : q2[0], send = b0 ? q2[0] : q2[1]; ykeep = keep + DPP_GET(send, 0xB1); }
#undef DPP_GET
            }
            Yraw[(size_t)(row0 + c * TC + t0 + j) * HW + h * 64 + row] = ykeep;
        }
        if (c + 1 < nch) { SCAN_STORE(c + 1); scan_signal(cnt, lane); }
    }
    scan_signal(cnt, lane); scan_wait(cnt, 4u * (base + (unsigned)nch + 1u)); base += (unsigned)nch + 1u;
    *(f32x4*)(Sout + row * 64 + 4 * j) = S;
#undef SCAN_LOAD
#undef SCAN_STORE
}

__global__ void __launch_bounds__(512, 2) mega(Params p) {
    extern __shared__ __attribute__((aligned(16))) unsigned char smem[];
    LAS unsigned char* lds = (LAS unsigned char*)smem;
    cg::grid_group grid = cg::this_grid();
    const int tid = threadIdx.x, lane = tid & 63, wave = __builtin_amdgcn_readfirstlane(tid >> 6);
    const int G = gridDim.x, bx = blockIdx.x, gw = bx * 8 + wave, NGW = G * 8;
    unsigned char* ws = p.ws; float* out = p.out;
    const float* x_p = p.in[0]; const float* x_s = p.in[1];
    bf16_t* WA = (bf16_t*)(ws + WS_WA); bf16_t* WB = (bf16_t*)(ws + WS_WB); bf16_t* WATT = (bf16_t*)(ws + WS_WATT); bf16_t* WRW = (bf16_t*)(ws + WS_WRW);
    bf16_t* WOUT = (bf16_t*)(ws + WS_WOUT); bf16_t* WL = (bf16_t*)(ws + WS_WL); bf16_t* LIN = (bf16_t*)(ws + WS_WB);
    bf16_t* H = (bf16_t*)(ws + WS_E); bf16_t* ATTO = (bf16_t*)(ws + WS_E); bf16_t* RWY = (bf16_t*)(ws + WS_E + SZ_Q);
    bf16_t* ACT = (bf16_t*)(ws + WS_FG); float* Y = (float*)(ws + WS_Y); float* PB = (float*)(ws + WS_PB);
    bf16_t* QB = (bf16_t*)(ws + WS_QB); bf16_t* KB = (bf16_t*)(ws + WS_KB);
    float* WD = (float*)(ws + WS_W); float* AA = (float*)(ws + WS_A); bf16_t* GG = (bf16_t*)(ws + WS_G); float* YR = (float*)(ws + WS_YR);
    bf16_t* VT = (bf16_t*)(ws + WS_VT); bf16_t* KC = (bf16_t*)(ws + WS_KC); bf16_t* VS = (bf16_t*)(ws + WS_VS);
    float* PART = (float*)(ws + WS_RKV + 48 * 1024 * 1024);
    float* RKV = (float*)(ws + WS_RKV); bf16_t* MIX = (bf16_t*)(ws + WS_RKV); bf16_t* GT = (bf16_t*)(ws + WS_GT);
    float* X1 = out + O_Y;
    LAS float* scr = (LAS float*)(lds + wave * 8448);
    const int lo = p.ph_lo, hi = p.ph_hi;
#define IN(k) (lo <= (k) && (k) < hi)
#define SEAM(k) do { if (IN(k) && IN((k) + 1)) { if ((k) == 0) { grid.sync(); xbar = xcd_barrier_post(barw, xst); } else xcd_barrier(xbar); } } while (0)
    pg8::StaticOrder S; pg8::SplitOrder SS;
    unsigned* barw = (unsigned*)(ws + WS_BAR); volatile LAS unsigned* xst = (volatile LAS unsigned*)(lds + LDS_BYTES - 16);
    XcdBarrier xbar; xbar.bar = barw; xbar.x = 0; xbar.st = xst;
    if (tid < 4) xst[tid] = 0u;
    if (bx == 0) for (int i = tid; i < XCD_BAR_WORDS; i += 512) barw[i] = 0u;

    if (IN(0)) {
        constexpr int I_1 = 32 * 352, I_2 = 88 * 64, I_A = 16 * 64, I_O = 32 * 64;
#define TR_SCR scr
#define RES_P0(idx, jb) do { jb.W = p.in[8]; jb.WT = WA; jb.K = D; jb.N = 2 * FF; jb.item = (idx); jb.sw = 1; } while (0)
        TR_RUN(gw, I_1, NGW, RES_P0);
#undef TR_SCR
        for (int i = bx * 512 + tid; i < 64 * HW / 2; i += G * 512) ((unsigned*)(KC + (size_t)DB * KCAT * HW))[i] = 0u;
        for (int i = bx * 512 + tid; i < DB * 16 * 64 * 24; i += G * 512) { const int rr = i / 24, cc = i - rr * 24; ((unsigned*)(VS + (size_t)rr * VTS + KCAT))[cc] = 0u; }
        for (int r = gw; r < M; r += NGW) { const float* xr = r < MP ? x_p + (size_t)r * D : x_s + (size_t)(r - MP) * D;
            f32x4 v[8]; float s = 0.f;
#pragma unroll
            for (int j = 0; j < 8; ++j) { v[j] = ((const f32x4*)xr)[lane + 64 * j]; s += (v[j][0] * v[j][0] + v[j][1] * v[j][1]) + (v[j][2] * v[j][2] + v[j][3] * v[j][3]); }
            const float rs = rsqrtf(wave_sum(s) * (1.f / D) + RMS_EPS);
#pragma unroll
            for (int j = 0; j < 8; ++j) { const f32x4 g = ((const f32x4*)p.in[6])[lane + 64 * j]; u32x2 w; w.x = pk2(v[j][0] * rs * g[0], v[j][1] * rs * g[1]); w.y = pk2(v[j][2] * rs * g[2], v[j][3] * rs * g[3]);
                ((u32x2*)(H + (size_t)r * D))[lane + 64 * j] = w; } }
    }
    SEAM(0);
    if (IN(1)) { __syncthreads(); S.init(M, 2 * FF, G, bx, D); pg8::gemm_phase(lds, pg8::Gemm{H, WA, M, 2 * FF, D}, S, EpiSwiglu{ACT});
        const int nlast = (33 * 44) % G, nidle = (nlast ? G - nlast : G);
        if (bx >= G - nidle) { const int wi = (bx - (G - nidle)) * 8 + wave, nw = nidle * 8; constexpr int I_2 = 88 * 64;
#define TR_SCR scr
#define RES_P1(idx, jb) do { jb.W = p.in[9]; jb.WT = WB; jb.K = FF; jb.N = D; jb.item = (idx); jb.sw = 0; } while (0)
            TR_RUN(wi, I_2, nw, RES_P1);
#undef TR_SCR
            { const int ci = bx - (G - nidle);
        for (int i0 = ci * 512 + tid; i0 < 3072 * 512; i0 += 4 * nidle * 512) { float v4[4];
#pragma unroll
            for (int u = 0; u < 4; ++u) { const int i = i0 + u * nidle * 512; float v = 0.f; if (i < 3072 * 512) { const int n = i >> 9, k = i & 511, sec = n >> 10, c = n & 1023;
                if (sec == 0) { if (k < 96) v = p.in[17][k * HW + c]; } else if (sec == 1) { if (k >= 96 && k < 192) v = p.in[19][(k - 96) * HW + c]; } else { if (k >= 192 && k < 448) v = p.in[20][(k - 192) * HW + c]; } } v4[u] = v; }
#pragma unroll
            for (int u = 0; u < 4; ++u) { const int i = i0 + u * nidle * 512; if (i < 3072 * 512) WL[i] = (bf16_t)(pk2(v4[u], 0.f) & 0xffffu); } }
            }
        } }
    SEAM(1);
    if (IN(2)) { SS.init(M, D, G, bx, FF); pg8::gemm_phase(lds, pg8::Gemm{ACT, WB, M, D, FF}, SS, EpiF32{Y, D, PART}); }
    SEAM(2);
    if (IN(3)) {
        for (int i = bx; i < MS; i += G) resnorm_row_block(x_s + (size_t)i * D, PART + (size_t)i * D, FF / 256, 0.5f, p.in[7], p.in[10], X1 + (size_t)(MP + i) * D, H + (size_t)(MP + i) * D, (LAS float*)lds, wave);
        RESNORM_ROWS(x_p, 0.5f, p.in[7], p.in[10], H);
        __syncthreads();
#define TR_SCR scr
#define RES_P3(idx, jb) do { jb.W = p.in[12]; jb.WT = WA; jb.K = D; jb.N = NIN; jb.item = (idx); jb.sw = 0; } while (0)
        TR_RUN(gw, 32 * (NIN / 32), NGW, RES_P3);
#undef TR_SCR
        for (int i = bx * 512 + tid; i < (NINP - NIN) * D / 2; i += G * 512) ((unsigned*)(WA + (size_t)NIN * D))[i] = 0u;
    }
    SEAM(3);
    if (IN(4)) { __syncthreads(); S.init(M, NINP, G, bx, D); pg8::gemm_phase(lds, pg8::Gemm{H, WA, M, NINP, D}, S, EpiWin{QB, KB, KC, VT, VS, GT, PB, out});
        const int nlast = (33 * 42) % G, nidle = (nlast ? G - nlast : G);
        if (bx >= G - nidle) { const int ci = bx - (G - nidle);
        for (int i0 = ci * 512 + tid; i0 < DB * NPAST * (HW / 4); i0 += 4 * nidle * 512) { f32x4 v4[4];
#pragma unroll
            for (int u = 0; u < 4; ++u) { const int i = i0 + u * nidle * 512; if (i < DB * NPAST * (HW / 4)) v4[u] = __builtin_nontemporal_load((const f32x4*)p.in[2] + i); }
#pragma unroll
            for (int u = 0; u < 4; ++u) { const int i = i0 + u * nidle * 512; if (i < DB * NPAST * (HW / 4)) { const int c4 = i & 255, rj = i >> 8, b = rj >> 9, jj = rj & 511; const f32x4 v = v4[u];
                u32x2 w; w.x = pk2(v[0], v[1]); w.y = pk2(v[2], v[3]); *(u32x2*)(KC + ((size_t)b * KCAT + jj) * HW + 4 * c4) = w; } } }
        for (int i0 = ci * 512 + tid; i0 < DB * 16 * 64 * 64; i0 += 2 * nidle * 512) { float t16[2][8];
#pragma unroll
            for (int u = 0; u < 2; ++u) { const int i = i0 + u * nidle * 512; if (i < DB * 16 * 64 * 64) { const int d = i & 63, jg = (i >> 6) & 63, hh = (i >> 12) & 15, b = i >> 16;
                const float* src = p.in[3] + ((size_t)b * NPAST + jg * 8) * HW + hh * 64 + d;
#pragma unroll
                for (int e = 0; e < 8; ++e) t16[u][e] = __builtin_nontemporal_load(src + e * HW); } }
#pragma unroll
            for (int u = 0; u < 2; ++u) { const int i = i0 + u * nidle * 512; if (i < DB * 16 * 64 * 64) { const int d = i & 63, jg = (i >> 6) & 63, hh = (i >> 12) & 15, b = i >> 16; u32x4 w;
                w.x = pk2(t16[u][0], t16[u][1]); w.y = pk2(t16[u][2], t16[u][3]); w.z = pk2(t16[u][4], t16[u][5]); w.w = pk2(t16[u][6], t16[u][7]);
                *(u32x4*)(VS + ((size_t)(b * 16 + hh) * 64 + d) * VTS + jg * 8) = w; } } }
            { const int wi = ci * 8 + wave, nw = nidle * 8; constexpr int I_A = 16 * 64, I_O = 32 * 64;
#define TR_SCR scr
#define RES_P4(idx, jb) do { int r_ = (idx); \
                if (r_ < I_A) { jb.W = p.in[14]; jb.WT = WATT; jb.K = HW; jb.N = D; jb.item = r_; jb.sw = 0; } \
                else if ((r_ -= I_A) < I_A) { jb.W = p.in[26]; jb.WT = WRW; jb.K = HW; jb.N = D; jb.item = r_; jb.sw = 0; } \
                else { r_ -= I_A; jb.W = p.in[27]; jb.WT = WOUT; jb.K = D; jb.N = D; jb.item = r_; jb.sw = 0; } } while (0)
              TR_RUN(wi, 2 * I_A + I_O, nw, RES_P4);
#undef TR_SCR
            }
        } }
    SEAM(4);
    if (IN(5)) {
        const float* mu = p.in[15];
        for (int r = gw; r < M; r += NGW) {
            const bool smp = r >= MP; const int b = smp ? ((r - MP) >> 4) : (r >> 11), t = smp ? ((r - MP) & 15) : (r & 2047);
            const float* pr = PB + (size_t)r * SW; const float* pv = t > 0 ? pr - SW : (smp ? p.in[5] + (size_t)b * SW : nullptr);
            float* so = nullptr; if (smp) { if (t == DT - 1) so = out + O_SHS + (size_t)b * SW; } else { if (t == SEQ - 1) so = out + O_SHP + (size_t)b * SW; }
            for (int ch0 = lane; ch0 < SW / 4; ch0 += 64 * 7) {
                f32x4 av[7], qv[7], mv[7];
#pragma unroll
                for (int u = 0; u < 7; ++u) { const int ch = ch0 + 64 * u; if (ch < SW / 4) { av[u] = ((const f32x4*)pr)[ch]; qv[u] = pv ? ((const f32x4*)pv)[ch] : (f32x4){0.f, 0.f, 0.f, 0.f}; mv[u] = ((const f32x4*)mu)[ch]; } }
#pragma unroll
                for (int u = 0; u < 7; ++u) { const int ch = ch0 + 64 * u; if (ch < SW / 4) { const int c = ch * 4; const f32x4 a = av[u]; const f32x4 xm = a + (qv[u] - a) * mv[u];
                if (so) ((f32x4*)so)[ch] = a;
                if (c < 3072) { *(f32x4*)(RKV + (size_t)(c >> 10) * M * HW + (size_t)r * HW + (c & 1023)) = xm; }
                else { float o[4]; int dc;
                    if (c < 3168) { dc = c - 3072;
#pragma unroll
                        for (int i = 0; i < 4; ++i) { const float e = __expf(2.f * xm[i]); o[i] = 1.f - 2.f / (e + 1.f); } }
                    else if (c < 3264) { dc = 96 + c - 3168;
#pragma unroll
                        for (int i = 0; i < 4; ++i) o[i] = xm[i]; }
                    else { dc = 192 + c - 3264;
#pragma unroll
                        for (int i = 0; i < 4; ++i) o[i] = sigmoidf_(xm[i]); }
                    u32x2 w; w.x = pk2(o[0], o[1]); w.y = pk2(o[2], o[3]); *(u32x2*)(LIN + (size_t)r * 512 + dc) = w; } } }
            }
            if (lane < 32) ((unsigned*)(LIN + (size_t)r * 512 + 448))[lane] = 0u;
        }
    }
    SEAM(5);
    if (IN(6)) { __syncthreads(); S.init(M, 3072, G, bx, 512); pg8::gemm_phase(lds, pg8::Gemm{LIN, WL, M, 3072, 512}, S, EpiLora{WD, AA, GG, p.in[16], p.in[18]}); }
    SEAM(6);
    if (IN(7)) {
        LAS float* biasT = (LAS float*)(lds + 2 * CH_FLOATS * 4);
        LAS unsigned* cnt = (LAS unsigned*)(lds + 2 * CH_FLOATS * 4 + 16 * 257 * 4);
        for (int i = tid; i < 16 * 257; i += 512) biasT[i] = p.in[13][i];
        if (tid == 0) *cnt = 0u;
        __syncthreads();
        const float* Rr = RKV; const float* Kr = RKV + (size_t)M * HW; const float* Vr = RKV + 2 * (size_t)M * HW;
        if (wave < 4) {
            unsigned base = 0u;
            for (int un = bx; un < 1024; un += G) { const int chain = un >> 2, qt = un & 3, b = chain >> 4, h = chain & 15;
                scan_unit4((LAS float*)lds, cnt, base, Rr, Kr, Vr, WD, AA, MP + b * DT, DT, h, qt, p.in[4] + (size_t)chain * 4096, out + O_WKVS + (size_t)chain * 4096, YR, p.in[21], p.in[22]); }
            for (int un = bx; un < 256; un += G) { const int chain = un >> 2, qt = un & 3, b = chain >> 4, h = chain & 15;
                scan_unit4((LAS float*)lds, cnt, base, Rr, Kr, Vr, WD, AA, b * SEQ, SEQ, h, qt, nullptr, out + O_WKVP + (size_t)chain * 4096, YR, p.in[21], p.in[22]); }
        } else {
            const int w4 = bx * 4 + (wave - 4), NW4 = G * 4;
            for (int wu = w4; wu < 8192 + 256; wu += NW4) {
                if (wu < 8192) { const int qg = wu & 3, h = (wu >> 2) & 15, c = (wu >> 6) & 31, b = wu >> 11; const int m0 = b * SEQ + c * 64 + qg * 16;
                    const int klo = c >= 8 ? (c - 8) * 64 : 0, khi = (c + 1) * 64;
                    attn_unit(QB + (size_t)m0 * HW + h * 64, KB + (size_t)b * SEQ * HW + h * 64, VT + (size_t)(b * 16 + h) * 64 * SEQ, SEQ, klo, (khi - klo) >> 6, khi, c * 64 + qg * 16,
                              biasT + h * 257, ATTO + (size_t)m0 * HW + h * 64, lane); }
                else { const int sidx = wu - 8192, h = sidx & 15, b = sidx >> 4; const int m0 = MP + b * DT;
                    attn_unit(QB + (size_t)m0 * HW + h * 64, KC + (size_t)b * KCAT * HW + h * 64, VS + (size_t)(b * 16 + h) * 64 * VTS, VTS, 0, 9, KCAT, NPAST,
                              biasT + h * 257, ATTO + (size_t)m0 * HW + h * 64, lane); }
            }
            LAS float* scr7 = (LAS float*)(lds + 114816 + (wave - 4) * 8448);
            constexpr int I_1 = 32 * 352, I_2 = 88 * 64, I_A = 16 * 64, I_O = 32 * 64;
#define TR_SCR scr7
#define RES_P7(idx, jb) do { jb.W = p.in[30]; jb.WT = WA; jb.K = D; jb.N = 2 * FF; jb.item = (idx); jb.sw = 1; } while (0)
            TR_RUN(w4, I_1, NW4, RES_P7);
#undef TR_SCR
        }
    }
    SEAM(7);
    if (IN(8)) {
        const float* Rr = RKV; const float* Kr = RKV + (size_t)M * HW; const float* Vr = RKV + 2 * (size_t)M * HW;
        for (int r = gw; r < M; r += NGW) { const size_t o = (size_t)r * HW + lane * 16; const int c0 = lane * 16;
            f32x4 y[4], rr[4], kk[4], vv[4], aa[4];
#pragma unroll
            for (int i = 0; i < 4; ++i) { y[i] = *(const f32x4*)(YR + o + 4 * i); rr[i] = *(const f32x4*)(Rr + o + 4 * i); kk[i] = *(const f32x4*)(Kr + o + 4 * i); vv[i] = *(const f32x4*)(Vr + o + 4 * i); aa[i] = *(const f32x4*)(AA + o + 4 * i); }
            float s = 0.f, bn = 0.f;
#pragma unroll
            for (int i = 0; i < 4; ++i) { const f32x4 ka = *(const f32x4*)(p.in[22] + c0 + 4 * i), rk = *(const f32x4*)(p.in[23] + c0 + 4 * i);
#pragma unroll
                for (int e = 0; e < 4; ++e) { s += y[i][e]; bn += rr[i][e] * (kk[i][e] * (1.f + (aa[i][e] - 1.f) * ka[e])) * rk[e]; } }
            s += __shfl_xor(s, 1); s += __shfl_xor(s, 2); bn += __shfl_xor(bn, 1); bn += __shfl_xor(bn, 2);
            const float mean = s * (1.f / 64.f); float q = 0.f;
#pragma unroll
            for (int i = 0; i < 4; ++i)
#pragma unroll
                for (int e = 0; e < 4; ++e) { const float dlt = y[i][e] - mean; q += dlt * dlt; }
            q += __shfl_xor(q, 1); q += __shfl_xor(q, 2);
            const float rstd = rsqrtf(q * (1.f / 64.f) + GN_EPS);
            const u32x4 g0 = *(const u32x4*)(GG + o), g1 = *(const u32x4*)(GG + o + 8);
            const unsigned gws[8] = {g0.x, g0.y, g0.z, g0.w, g1.x, g1.y, g1.z, g1.w};
            unsigned ow[8];
#pragma unroll
            for (int i = 0; i < 4; ++i) { const f32x4 lw = *(const f32x4*)(p.in[24] + c0 + 4 * i), lb = *(const f32x4*)(p.in[25] + c0 + 4 * i); float ov[4];
#pragma unroll
                for (int e = 0; e < 4; ++e) { const unsigned gwd = gws[2 * i + (e >> 1)]; const float gf = (e & 1) ? __uint_as_float(gwd & 0xffff0000u) : __uint_as_float(gwd << 16);
                    ov[e] = ((y[i][e] - mean) * rstd * lw[e] + lb[e] + bn * vv[i][e]) * gf; }
                ow[2 * i] = pk2(ov[0], ov[1]); ow[2 * i + 1] = pk2(ov[2], ov[3]); }
            u32x4 w0; w0.x = ow[0]; w0.y = ow[1]; w0.z = ow[2]; w0.w = ow[3]; u32x4 w1; w1.x = ow[4]; w1.y = ow[5]; w1.z = ow[6]; w1.w = ow[7];
            *(u32x4*)(RWY + o) = w0; *(u32x4*)(RWY + o + 8) = w1; }
    }
    SEAM(8);
    if (IN(9)) { __syncthreads(); SS.init(M, D, G, bx, HW);
        pg8::gemm_phase(lds, pg8::Gemm{ATTO, WATT, M, D, HW}, SS, EpiGateA{Y, GT, PART});
        pg8::gemm_phase(lds, pg8::Gemm{RWY, WRW, M, D, HW}, SS, EpiGateB{Y, GT, MIX, PART + (size_t)4 * MS * D});
        xcd_barrier(xbar);
        for (int i = bx; i < MS; i += G) { f32x4 a = (f32x4){0.f, 0.f, 0.f, 0.f};
#pragma unroll
            for (int q = 0; q < 8; ++q) a += ((const f32x4*)(PART + ((size_t)q * MS + i) * D))[tid];
            u32x2 w; w.x = pk2(a[0], a[1]); w.y = pk2(a[2], a[3]); ((u32x2*)(MIX + (size_t)(MP + i) * D))[tid] = w; }
    }
    SEAM(9);
    if (IN(10)) { SS.init(M, D, G, bx, D); pg8::gemm_phase(lds, pg8::Gemm{MIX, WOUT, M, D, D}, SS, EpiF32{Y, D, PART}); }
    SEAM(10);
    if (IN(11)) {
        for (int i = bx; i < MS; i += G) resnorm_row_block(X1 + (size_t)(MP + i) * D, PART + (size_t)i * D, D / 256, 1.f, p.in[11], p.in[28], X1 + (size_t)(MP + i) * D, H + (size_t)(MP + i) * D, (LAS float*)lds, wave);
        RESNORM_ROWS(X1, 1.f, p.in[11], p.in[28], H); }
    SEAM(11);
    if (IN(12)) { __syncthreads(); S.init(M, 2 * FF, G, bx, D); pg8::gemm_phase(lds, pg8::Gemm{H, WA, M, 2 * FF, D}, S, EpiSwiglu{ACT});
        const int nlast = (33 * 44) % G, nidle = (nlast ? G - nlast : G);
        if (bx >= G - nidle) { const int wi = (bx - (G - nidle)) * 8 + wave, nw = nidle * 8; constexpr int I_2 = 88 * 64;
#define TR_SCR scr
#define RES_P12(idx, jb) do { jb.W = p.in[31]; jb.WT = WB; jb.K = FF; jb.N = D; jb.item = (idx); jb.sw = 0; } while (0)
            TR_RUN(wi, I_2, nw, RES_P12);
#undef TR_SCR
        } }
    SEAM(12);
    if (IN(13)) { SS.init(M, D, G, bx, FF); pg8::gemm_phase(lds, pg8::Gemm{ACT, WB, M, D, FF}, SS, EpiF32{Y, D, PART}); }
    SEAM(13);
    if (IN(14)) {
        for (int i = bx; i < MS; i += G) resnorm_row_block(X1 + (size_t)(MP + i) * D, PART + (size_t)i * D, FF / 256, 0.5f, p.in[29], nullptr, X1 + (size_t)(MP + i) * D, nullptr, (LAS float*)lds, wave);
        RESNORM_ROWS(X1, 0.5f, p.in[29], (const float*)nullptr, (bf16_t*)nullptr); }
}

extern "C" void kernel_launch(void* const* d_in, const int* in_sizes, int n_in, void* d_out, int out_size, void* d_ws, size_t ws_size, hipStream_t stream) {
    static int grid = 0;
    if (grid == 0) {
        if (n_in != 32 || ws_size < WS_END) { fprintf(stderr, "kernel_launch: unexpected n_in %d or workspace %zu < %zu\n", n_in, ws_size, (size_t)WS_END); grid = -1; return; }
        int dev = 0, cus = 0, per_cu = 0;
        hipGetDevice(&dev);
        hipDeviceGetAttribute(&cus, hipDeviceAttributeMultiprocessorCount, dev);
        if (hipFuncSetAttribute((const void*)mega, hipFuncAttributeMaxDynamicSharedMemorySize, LDS_BYTES) != hipSuccess) { fprintf(stderr, "kernel_launch: hipFuncSetAttribute failed\n"); grid = -1; return; }
        hipOccupancyMaxActiveBlocksPerMultiprocessor(&per_cu, (const void*)mega, 512, LDS_BYTES);
        (void)hipGetLastError();
        if (per_cu < 1) per_cu = 1;
        grid = cus * per_cu;
        if (grid > 256) grid = 256;
    }
    if (grid < 0) return;
    Params p{};
    for (int i = 0; i < 32; ++i) p.in[i] = (const float*)d_in[i];
    p.out = (float*)d_out; p.ws = (unsigned char*)d_ws; p.ph_lo = 0; p.ph_hi = 15;
    void* args[] = {&p};
    hipError_t e = hipLaunchCooperativeKernel((const void*)mega, dim3(grid), dim3(512), args, LDS_BYTES, stream);
    if (e != hipSuccess) fprintf(stderr, "cooperative launch failed: %s (grid %d)\n", hipGetErrorString(e), grid);
}
```

```cpp
#include <hip/hip_runtime.h>
#include <hip/hip_cooperative_groups.h>
#include <cstdio>
#include <cstdint>
namespace cg = cooperative_groups;

#define LAS __attribute__((address_space(3)))
typedef unsigned short bf16_t;
typedef short bf16x8 __attribute__((ext_vector_type(8)));
typedef float f32x4 __attribute__((ext_vector_type(4)));
typedef unsigned u32x4 __attribute__((ext_vector_type(4)));
typedef unsigned u32x2 __attribute__((ext_vector_type(2)));
typedef float f32x2 __attribute__((ext_vector_type(2)));

constexpr int D = 2048, MP = 8192, MS = 256, M = MP + MS, FF = 5632, NIN = 10688, NINP = 10752, SW = 3520, HW = 1024;
constexpr int SEQ = 2048, NB = 4, DB = 16, DT = 16, NPAST = 512, KCAT = NPAST + DT  , VTS = 576;
constexpr float RMS_EPS = 1e-6f, GN_EPS = 64e-5f;

constexpr size_t O_Y = 0, O_KP = (size_t)M * D, O_VP = O_KP + 2097152, O_WKVP = O_VP + 2097152, O_SHP = O_WKVP + 262144, O_KS = O_SHP + 14080,
                 O_VS = O_KS + 262144, O_WKVS = O_VS + 262144, O_SHS = O_WKVS + 1048576;

constexpr size_t SZ_H = (size_t)M * D * 2;
constexpr size_t SZ_Q = (size_t)M * HW * 2;
constexpr size_t SZ_F1 = (size_t)M * HW * 4;
constexpr size_t WS_WA = 0;
constexpr size_t WS_WB = WS_WA + (size_t)11264 * 2048 * 2;
constexpr size_t WS_WATT = WS_WB + (size_t)2048 * 5632 * 2;
constexpr size_t WS_WRW = WS_WATT + (size_t)2048 * 1024 * 2;
constexpr size_t WS_WOUT = WS_WRW + (size_t)2048 * 1024 * 2;
constexpr size_t WS_WL = WS_WOUT + (size_t)2048 * 2048 * 2;
constexpr size_t WS_E = WS_WL + (size_t)3072 * 512 * 2;
constexpr size_t WS_FG = WS_E + SZ_H;
constexpr size_t SZ_ACT = (size_t)M * FF * 2;
constexpr size_t WS_Y = WS_FG + SZ_ACT;
constexpr size_t SZ_FG = SZ_ACT + (size_t)M * D * 4;
constexpr size_t WS_PB = WS_FG;
constexpr size_t WS_QB = WS_FG + SZ_FG - 2 * SZ_Q;
constexpr size_t WS_KB = WS_QB + SZ_Q;
constexpr size_t WS_W = WS_FG;
constexpr size_t WS_A = WS_W + SZ_F1;
constexpr size_t WS_G = WS_A + SZ_F1;
constexpr size_t WS_YR = WS_G + SZ_Q;
constexpr size_t WS_VT = WS_FG + SZ_FG;
constexpr size_t WS_KC = WS_VT + (size_t)NB * 16 * 64 * SEQ * 2;
constexpr size_t WS_VS = WS_KC + (size_t)(DB * KCAT + 64) * HW * 2;
constexpr size_t WS_RKV = WS_VS + (size_t)DB * 16 * 64 * VTS * 2;
constexpr size_t WS_GT = WS_RKV + 3 * SZ_F1;
constexpr size_t WS_BAR = WS_GT + (size_t)M * 4096 * 2;
constexpr size_t WS_END = WS_BAR + 16384;
static_assert(WS_YR + SZ_F1 <= WS_QB, "overlay");
static_assert(WS_PB + (size_t)M * SW * 4 <= WS_QB, "overlay");

constexpr int LDS_BYTES = 152 * 1024;

struct Params { const float* in[32]; float* out; unsigned char* ws; int ph_lo, ph_hi; };

__device__ __forceinline__ unsigned pk2(float lo, float hi) { unsigned r; asm volatile("v_cvt_pk_bf16_f32 %0, %1, %2" : "=v"(r) : "v"(lo), "v"(hi)); return r; }
__device__ __forceinline__ float bf2f(unsigned short b) { return __uint_as_float(((unsigned)b) << 16); }
__device__ __forceinline__ float wave_sum(float v) {
#pragma unroll
    for (int o = 1; o < 64; o <<= 1) v += __shfl_xor(v, o);
    return v;
}
#define DPP_ADD(v, ctrl) ((v) + __builtin_bit_cast(float, __builtin_amdgcn_update_dpp(0, __builtin_bit_cast(int, (v)), (ctrl), 0xf, 0xf, true)))
__device__ __forceinline__ float row16_sum(float v) {
    v = DPP_ADD(v, 0xB1); v = DPP_ADD(v, 0x4E); v = DPP_ADD(v, 0x141); v = DPP_ADD(v, 0x128); return v;
}
__device__ __forceinline__ float sigmoidf_(float x) { return 1.f / (1.f + __expf(-x)); }
#define LDS_WAIT() asm volatile("s_waitcnt lgkmcnt(0)" ::: "memory")
__device__ __forceinline__ float fma_s(float a, float b, float c) { float r; asm("v_fma_f32 %0, %1, %2, %3" : "=v"(r) : "v"(a), "v"(b), "v"(c)); return r; }
__device__ __forceinline__ float mul_s(float a, float b) { float r; asm("v_mul_f32 %0, %1, %2" : "=v"(r) : "v"(a), "v"(b)); return r; }
__device__ __forceinline__ float add_s(float a, float b) { float r; asm("v_add_f32 %0, %1, %2" : "=v"(r) : "v"(a), "v"(b)); return r; }

#define XB_TMO      128
#define XB_XCNT(j)  (256  + 64 * (j))
#define XB_XSUB(j)  (1280 + 64 * (j))
#define XB_XGEN(j)  (2304 + 64 * (j))
#define XB_TOP      3328
#define XB_TOPGEN   3392
#define XCD_BAR_WORDS 3456
#define XB_SPIN_CAP (1u << 18)
__device__ __forceinline__ unsigned xb_ld(unsigned* p)              { return __hip_atomic_load(p, __ATOMIC_RELAXED, __HIP_MEMORY_SCOPE_AGENT); }
__device__ __forceinline__ unsigned xb_add(unsigned* p, unsigned v) { return __hip_atomic_fetch_add(p, v, __ATOMIC_RELAXED, __HIP_MEMORY_SCOPE_AGENT); }
__device__ __forceinline__ unsigned xb_xcc_id() { return (unsigned)__builtin_amdgcn_s_getreg((3 << 11) | 20) & 0xFu; }
#define XB_SPIN(cond, bar) do { unsigned _sp = 0; while (cond) { __builtin_amdgcn_s_sleep(1); \
    if ((++_sp & 255u) == 0u) { if (xb_ld(&(bar)[XB_TMO])) break; if (_sp > XB_SPIN_CAP) { atomicAdd(&(bar)[XB_TMO], 1u); break; } } } } while (0)
struct XcdBarrier { unsigned* bar; unsigned x; volatile LAS unsigned* st; };
__device__ __forceinline__ XcdBarrier xcd_barrier_post(unsigned* bar, volatile LAS unsigned* st) {
    XcdBarrier b; b.bar = bar; b.x = xb_xcc_id(); b.st = st;
    if (threadIdx.x == 0) (void)xb_add(&bar[XB_XCNT(b.x)], 1u);
    return b;
}
__device__ __forceinline__ void xcd_barrier_complete(unsigned* bar, unsigned x, unsigned& nloc, unsigned& nx) {
    const unsigned G = gridDim.x * gridDim.y * gridDim.z;
    unsigned sum, cnt, mine, sp = 0u;
    for (;;) {
        sum = 0u; cnt = 0u; mine = 0u;
#pragma unroll
        for (unsigned j = 0; j < 16; ++j) { const unsigned c = xb_ld(&bar[XB_XCNT(j)]); sum += c; cnt += (c > 0u) ? 1u : 0u; mine = (j == x) ? c : mine; }
        if (sum == G) break;
        __builtin_amdgcn_s_sleep(1);
        if ((++sp & 255u) == 0u) { if (xb_ld(&bar[XB_TMO])) break; if (sp > XB_SPIN_CAP) { atomicAdd(&bar[XB_TMO], 1u); break; } }
    }
    nloc = mine > 0u ? mine : 1u; nx = cnt > 0u ? cnt : 1u;
}
__device__ __forceinline__ void xcd_barrier(const XcdBarrier& b) {
    asm volatile("s_waitcnt vmcnt(0)" ::: "memory");
    __syncthreads();
    if (threadIdx.x == 0) {
        unsigned* bar = b.bar;
        __builtin_amdgcn_s_waitcnt(0);
        unsigned nloc = b.st[0], nx = b.st[1];
        if (nloc == 0u) { xcd_barrier_complete(bar, b.x, nloc, nx); b.st[0] = nloc; b.st[1] = nx; }
        const unsigned old = xb_add(&bar[XB_XSUB(b.x)], 1u);
        const unsigned gen = old / nloc;
        if (old + 1u == (gen + 1u) * nloc) {
            __builtin_amdgcn_fence(__ATOMIC_RELEASE, "agent");
            asm volatile("s_waitcnt vmcnt(0)" ::: "memory");
            const unsigned og = xb_add(&bar[XB_TOP], 1u);
            const unsigned tg = og / nx;
            if (og + 1u == (tg + 1u) * nx) xb_add(&bar[XB_TOPGEN], 1u);
            else XB_SPIN(xb_ld(&bar[XB_TOPGEN]) == tg, bar);
            __builtin_amdgcn_fence(__ATOMIC_ACQUIRE, "agent");
            xb_add(&bar[XB_XGEN(b.x)], 1u);
            asm volatile("s_waitcnt vmcnt(0)" ::: "memory");
        } else {
            XB_SPIN(xb_ld(&bar[XB_XGEN(b.x)]) == gen, bar);
            __builtin_amdgcn_fence(__ATOMIC_ACQUIRE, "agent");
            asm volatile("s_waitcnt vmcnt(0)" ::: "memory");
        }
    }
    __syncthreads();
}

namespace pg8 {
constexpr int BM = 256, BK = 64, HALF = 128, HTB = HALF * BK * 2, STAGE_BYTES = 8 * HTB, NXCD = 8, WGM = 4;
__device__ __forceinline__ int lds_byte(int r, int c) { const int st = (r >> 4) * 2 + (c >> 5), rr = r & 15, cc = c & 31, ob = rr * 64 + cc * 2; return st * 1024 + (ob ^ (((ob >> 9) & 1) << 5)); }
__device__ __forceinline__ void stage_rc(int b, int& R, int& C) { const int st = b / 1024, sb = b % 1024, swz = sb ^ (((sb >> 9) & 1) << 5); R = (st >> 1) * 16 + swz / 64; C = (st & 1) * 32 + (swz % 64) / 2; }
struct Unit { int pm, pn, k0, nt; };
struct Gemm { const bf16_t* A; const bf16_t* Bt; int M, N, K; };
struct StaticOrder {
    int nM, nN, nwg, G, c, ntk;
    __device__ __forceinline__ void init(int M_, int N_, int G_, int c_, int K_) { nM = M_ / BM; nN = N_ / BM; nwg = nM * nN; G = G_; c = c_; ntk = K_ / BK; }
    __device__ __forceinline__ bool next(int i, Unit& u) const {
        const long L = (long)i * G + c; if (L >= nwg) return false;
        int wgid = (int)L; { const int q = nwg / NXCD, r = nwg % NXCD, xcd = wgid % NXCD, off = wgid / NXCD; wgid = (xcd < r ? xcd * (q + 1) : r * (q + 1) + (xcd - r) * q) + off; }
        const int nig = WGM * nN, gid = wgid / nig, fm = gid * WGM, gsz = (nM - fm) < WGM ? (nM - fm) : WGM;
        u.pm = fm + ((wgid % nig) % gsz); u.pn = (wgid % nig) / gsz; u.k0 = 0; u.nt = ntk; return true;
    }
};
struct SplitOrder {
    int nN, nfull, nsplit, G, c, ntk;
    __device__ __forceinline__ void init(int, int N_, int G_, int c_, int K_) { nN = N_ / BM; nfull = 32 * nN; ntk = K_ / BK; nsplit = nN * (ntk / 4); G = G_; c = c_; }
    __device__ __forceinline__ bool next(int i, Unit& u) const {
        const int L = i * G + c;
        if (L < nfull) { int wgid = L; { const int q = nfull / NXCD, xcd = wgid % NXCD, off = wgid / NXCD; wgid = xcd * q + off; }
            const int nig = WGM * nN; const int gid = wgid / nig, fm = gid * WGM;
            u.pm = fm + ((wgid % nig) % WGM); u.pn = (wgid % nig) / WGM; u.k0 = 0; u.nt = ntk; return true; }
        const int r = L - nfull; if (r >= nsplit) return false;
        u.pm = 32; u.pn = r % nN; u.k0 = (r / nN) * 4; u.nt = 4; return true;
    }
};

template <class Epi, class Sched>
__device__ __forceinline__ void gemm_phase(LAS unsigned char* lds, const Gemm g, const Sched& S, const Epi& E) {
    const int tid = threadIdx.x, wid = __builtin_amdgcn_readfirstlane(tid >> 6), lane = tid & 63, wr = wid >> 2, wc = wid & 3, fr = lane & 15, fq = lane >> 4;
    const int K = g.K;
    unsigned voffA[2];
#pragma unroll
    for (int i = 0; i < 2; ++i) { int R, C; stage_rc(tid * 16 + i * 8192, R, C); voffA[i] = (unsigned)(R * K + C) * 2u; }
    const size_t kstep = (size_t)(BK * 2);
    const size_t hstep = (size_t)HALF * K * 2;
    const size_t tstep = 2 * hstep;
    const unsigned ldsw = (unsigned)wid * 1024u;
    const int aoff = lds_byte(wr * 64 + fr, fq * 8), boff = lds_byte(wc * 32 + fr, fq * 8);
#define PG8_SA(b, h) (((b) * 2 + (h)) * HTB)
#define PG8_SB(b, h) ((4 + (b) * 2 + (h)) * HTB)
#define PG8_STAGE(bufoff, gbase) do { _Pragma("unroll") for (int _i = 0; _i < 2; ++_i) \
        __builtin_amdgcn_global_load_lds((const unsigned*)((const char*)(gbase) + voffA[_i]), (LAS unsigned*)(lds + (bufoff) + ldsw + _i * 8192), 16, 0, 0); } while (0)
#define PG8_LDA(dst, b, h) do { _Pragma("unroll") for (int m = 0; m < 4; ++m) _Pragma("unroll") for (int k = 0; k < 2; ++k) dst[m][k] = *(const LAS bf16x8*)(lds + PG8_SA(b, h) + aoff + m * 2048 + k * 1024); } while (0)
#define PG8_LDB(dst, b, h) do { _Pragma("unroll") for (int n = 0; n < 2; ++n) _Pragma("unroll") for (int k = 0; k < 2; ++k) dst[n][k] = *(const LAS bf16x8*)(lds + PG8_SB(b, h) + boff + n * 2048 + k * 1024); } while (0)
#define PG8_MMA(ai, bj, At, Bt) do { __builtin_amdgcn_s_setprio(1); _Pragma("unroll") for (int m = 0; m < 4; ++m) _Pragma("unroll") for (int n = 0; n < 2; ++n) _Pragma("unroll") for (int k = 0; k < 2; ++k) \
        acc[ai][bj][m][n] = __builtin_amdgcn_mfma_f32_16x16x32_bf16(Bt[n][k], At[m][k], acc[ai][bj][m][n], 0, 0, 0); __builtin_amdgcn_s_setprio(0); } while (0)
#define PG8_WAIT_V(n) asm volatile("s_waitcnt vmcnt(" #n ")" ::: "memory")
#define PG8_WAIT_L(n) asm volatile("s_waitcnt lgkmcnt(" #n ")" ::: "memory")
#define PG8_BAR __builtin_amdgcn_s_barrier()
#define PG8_SCHED __builtin_amdgcn_sched_barrier(0)
    Unit cur, nxt; int ui = 0;
    if (!S.next(0, cur)) return;
    f32x4 acc[2][2][4][2];
#pragma unroll
    for (int a = 0; a < 2; ++a)
#pragma unroll
        for (int b = 0; b < 2; ++b)
#pragma unroll
            for (int m = 0; m < 4; ++m)
#pragma unroll
                for (int n = 0; n < 2; ++n) acc[a][b][m][n] = (f32x4){0.f, 0.f, 0.f, 0.f};
    bf16x8 At[4][2], B0[2][2], B1[2][2];
    const char* cA = (const char*)g.A + (size_t)cur.pm * tstep + (size_t)cur.k0 * kstep; const char* cB = (const char*)g.Bt + (size_t)cur.pn * tstep + (size_t)cur.k0 * kstep;
    PG8_STAGE(PG8_SB(0, 0), cB); PG8_STAGE(PG8_SB(0, 1), cB + hstep); PG8_STAGE(PG8_SA(0, 0), cA); PG8_STAGE(PG8_SA(0, 1), cA + hstep);
    if (wr == 1) PG8_BAR;
    PG8_WAIT_V(2); PG8_BAR;
    PG8_STAGE(PG8_SB(1, 0), cB + kstep); PG8_STAGE(PG8_SA(1, 0), cA + kstep); PG8_STAGE(PG8_SB(1, 1), cB + hstep + kstep);
    PG8_WAIT_V(6); PG8_BAR;
    for (;;) {
        const bool has_next = S.next(ui + 1, nxt);
        const char* nA = has_next ? (const char*)g.A + (size_t)nxt.pm * tstep + (size_t)nxt.k0 * kstep : cA; const char* nB = has_next ? (const char*)g.Bt + (size_t)nxt.pn * tstep + (size_t)nxt.k0 * kstep : cB;
        const int nt = cur.nt;
        for (int t = 0; t < nt; t += 2) {
            const bool last = (t == nt - 2);
            const char* a1 = cA + (size_t)(t + 1) * kstep;
            const char* a2 = last ? nA : cA + (size_t)(t + 2) * kstep; const char* b2 = last ? nB : cB + (size_t)(t + 2) * kstep;
            const char* a3 = a2 + kstep; const char* b3 = b2 + kstep;
            PG8_LDB(B0, 0, 0); PG8_LDB(B1, 0, 1); PG8_SCHED; PG8_LDA(At, 0, 0); PG8_STAGE(PG8_SA(1, 1), a1 + hstep);
            PG8_WAIT_V(8); PG8_WAIT_L(0); PG8_BAR; PG8_MMA(0, 0, At, B0); PG8_MMA(0, 1, At, B1); PG8_BAR; PG8_SCHED;
            PG8_LDA(At, 0, 1); PG8_STAGE(PG8_SB(0, 0), b2); PG8_STAGE(PG8_SB(0, 1), b2 + hstep); PG8_STAGE(PG8_SA(0, 0), a2);
            PG8_WAIT_V(8); PG8_WAIT_L(0); PG8_BAR; PG8_MMA(1, 0, At, B0); PG8_MMA(1, 1, At, B1); PG8_BAR; PG8_SCHED;
            PG8_LDB(B0, 1, 0); PG8_LDB(B1, 1, 1); PG8_SCHED; PG8_LDA(At, 1, 0); PG8_STAGE(PG8_SA(0, 1), a2 + hstep);
            PG8_WAIT_V(8); PG8_WAIT_L(0); PG8_BAR; PG8_MMA(0, 0, At, B0); PG8_MMA(0, 1, At, B1); PG8_BAR; PG8_SCHED;
            PG8_LDA(At, 1, 1); PG8_STAGE(PG8_SB(1, 0), b3); PG8_STAGE(PG8_SB(1, 1), b3 + hstep); PG8_STAGE(PG8_SA(1, 0), a3);
            PG8_WAIT_V(8); PG8_WAIT_L(0); PG8_BAR; PG8_MMA(1, 0, At, B0); PG8_MMA(1, 1, At, B1); PG8_BAR; PG8_SCHED;
        }
        if (wr == 0) PG8_BAR;
        E(acc, cur, wr, wc, fr, fq);
        if (!has_next) break;
#pragma unroll
        for (int a = 0; a < 2; ++a)
#pragma unroll
            for (int b = 0; b < 2; ++b)
#pragma unroll
                for (int m = 0; m < 4; ++m)
#pragma unroll
                    for (int n = 0; n < 2; ++n) acc[a][b][m][n] = (f32x4){0.f, 0.f, 0.f, 0.f};
        cur = nxt; cA = nA; cB = nB; ++ui;
        if (wr == 1) PG8_BAR;
    }
    PG8_WAIT_V(0);
    PG8_BAR;
#undef PG8_SA
#undef PG8_SB
#undef PG8_STAGE
#undef PG8_LDA
#undef PG8_LDB
#undef PG8_MMA
#undef PG8_WAIT_V
#undef PG8_WAIT_L
#undef PG8_BAR
#undef PG8_SCHED
}
}
using pg8::Unit;

#define EPI_ROW(ai, m) (u.pm * 256 + (ai) * 128 + wr * 64 + (m) * 16 + fr)
#define EPI_COL(bj, n) (u.pn * 256 + (bj) * 128 + wc * 32 + (n) * 16 + 4 * fq)

struct EpiF32 {
    float* C; int ldc; float* part;
    __device__ __forceinline__ void operator()(const f32x4 (&acc)[2][2][4][2], const Unit& u, int wr, int wc, int fr, int fq) const {
#pragma unroll
        for (int ai = 0; ai < 2; ++ai)
#pragma unroll
            for (int m = 0; m < 4; ++m) { float* rowp = (u.pm == 32 && part) ? part + ((size_t)(u.k0 >> 2) * MS + (EPI_ROW(ai, m) - MP)) * ldc : C + (size_t)EPI_ROW(ai, m) * ldc;
#pragma unroll
                for (int bj = 0; bj < 2; ++bj)
#pragma unroll
                    for (int n = 0; n < 2; ++n) { float* q = rowp + EPI_COL(bj, n); const f32x4 v = acc[ai][bj][m][n];
                        *(f32x4*)q = v; } }
    }
};
struct EpiSwiglu {
    bf16_t* O;
    __device__ __forceinline__ void operator()(const f32x4 (&acc)[2][2][4][2], const Unit& u, int wr, int wc, int fr, int fq) const {
#pragma unroll
        for (int ai = 0; ai < 2; ++ai)
#pragma unroll
            for (int m = 0; m < 4; ++m) { bf16_t* rowp = O + (size_t)EPI_ROW(ai, m) * FF + u.pn * 128 + wc * 32 + 4 * fq;
#pragma unroll
                for (int n = 0; n < 2; ++n) { const f32x4 g = acc[ai][0][m][n], up = acc[ai][1][m][n]; float o[4];
#pragma unroll
                    for (int i = 0; i < 4; ++i) o[i] = g[i] * up[i] / (1.f + __expf(-g[i]));
                    u32x2 w; w.x = pk2(o[0], o[1]); w.y = pk2(o[2], o[3]); *(u32x2*)(rowp + n * 16) = w; } }
    }
};
struct EpiWin {
    bf16_t *Q, *KB, *KC, *VT, *VS, *GT; float *PB, *out;
    __device__ __forceinline__ void operator()(const f32x4 (&acc)[2][2][4][2], const Unit& u, int wr, int wc, int fr, int fq) const {
#pragma unroll
        for (int ai = 0; ai < 2; ++ai)
#pragma unroll
            for (int m = 0; m < 4; ++m) { const int r = EPI_ROW(ai, m);
                const bool smp = r >= MP; const int b = smp ? ((r - MP) >> 4) : (r >> 11), t = smp ? ((r - MP) & 15) : (r & 2047);
#pragma unroll
                for (int bj = 0; bj < 2; ++bj)
#pragma unroll
                    for (int n = 0; n < 2; ++n) { const int c = EPI_COL(bj, n); const f32x4 v = acc[ai][bj][m][n];
                        if (c < 1024) { u32x2 w; w.x = pk2(v[0] * 0.125f, v[1] * 0.125f); w.y = pk2(v[2] * 0.125f, v[3] * 0.125f); *(u32x2*)(Q + (size_t)r * HW + c) = w; }
                        else if (c < 2048) { const int cc = c - 1024; u32x2 w; w.x = pk2(v[0], v[1]); w.y = pk2(v[2], v[3]);
                            if (smp) { *(u32x2*)(KC + ((size_t)b * KCAT + NPAST + t) * HW + cc) = w; *(f32x4*)(out + O_KS + ((size_t)b * DT + t) * HW + cc) = v; }
                            else { *(u32x2*)(KB + (size_t)r * HW + cc) = w; if (t >= SEQ - 512) *(f32x4*)(out + O_KP + ((size_t)b * 512 + (t - (SEQ - 512))) * HW + cc) = v; } }
                        else if (c < 3072) { const int cc = c - 2048, h = cc >> 6, d = cc & 63;
                            if (smp) { bf16_t* vp = VS + ((size_t)(b * 16 + h) * 64 + d) * VTS + NPAST + t;
#pragma unroll
                                for (int i = 0; i < 4; ++i) vp[(size_t)i * VTS] = (bf16_t)(pk2(v[i], 0.f) & 0xffffu);
                                *(f32x4*)(out + O_VS + ((size_t)b * DT + t) * HW + cc) = v; }
                            else { bf16_t* vp = VT + ((size_t)(b * 16 + h) * 64 + d) * SEQ + t;
#pragma unroll
                                for (int i = 0; i < 4; ++i) vp[(size_t)i * SEQ] = (bf16_t)(pk2(v[i], 0.f) & 0xffffu);
                                if (t >= SEQ - 512) *(f32x4*)(out + O_VP + ((size_t)b * 512 + (t - (SEQ - 512))) * HW + cc) = v; } }
                        else if (c < 3072 + SW) { *(f32x4*)(PB + (size_t)r * SW + (c - 3072)) = v; }
                        else if (c < NIN) { u32x2 w; w.x = pk2(sigmoidf_(v[0]), sigmoidf_(v[1])); w.y = pk2(sigmoidf_(v[2]), sigmoidf_(v[3])); *(u32x2*)(GT + (size_t)r * 4096 + (c - 3072 - SW)) = w; }
                    } }
    }
};
struct EpiLora {
    float *Wd, *Aa; bf16_t* Gg; const float *w0, *a0;
    __device__ __forceinline__ void operator()(const f32x4 (&acc)[2][2][4][2], const Unit& u, int wr, int wc, int fr, int fq) const {
#pragma unroll
        for (int ai = 0; ai < 2; ++ai)
#pragma unroll
            for (int m = 0; m < 4; ++m) { const int r = EPI_ROW(ai, m);
#pragma unroll
                for (int bj = 0; bj < 2; ++bj)
#pragma unroll
                    for (int n = 0; n < 2; ++n) { const int c = EPI_COL(bj, n); const f32x4 v = acc[ai][bj][m][n];
                        if (c < 1024) { const f32x4 z0 = *(const f32x4*)(w0 + c); f32x4 o;
#pragma unroll
                            for (int i = 0; i < 4; ++i) o[i] = __expf(-0.6065306597f * sigmoidf_(v[i] + z0[i]));
                            *(f32x4*)(Wd + (size_t)r * HW + c) = o; }
                        else if (c < 2048) { const int cc = c - 1024; const f32x4 z0 = *(const f32x4*)(a0 + cc); f32x4 o;
#pragma unroll
                            for (int i = 0; i < 4; ++i) o[i] = sigmoidf_(v[i] + z0[i]);
                            *(f32x4*)(Aa + (size_t)r * HW + cc) = o; }
                        else { const int cc = c - 2048; u32x2 w; w.x = pk2(v[0], v[1]); w.y = pk2(v[2], v[3]); *(u32x2*)(Gg + (size_t)r * HW + cc) = w; }
                    } }
    }
};
struct EpiGateA {
    float* T1; const bf16_t* GT; float* part;
    __device__ __forceinline__ void operator()(const f32x4 (&acc)[2][2][4][2], const Unit& u, int wr, int wc, int fr, int fq) const {
#pragma unroll
        for (int ai = 0; ai < 2; ++ai)
#pragma unroll
            for (int m = 0; m < 4; ++m) { const int r = EPI_ROW(ai, m);
#pragma unroll
                for (int bj = 0; bj < 2; ++bj)
#pragma unroll
                    for (int n = 0; n < 2; ++n) { const int c = EPI_COL(bj, n); const f32x4 v = acc[ai][bj][m][n];
                        const u32x2 gw = *(const u32x2*)(GT + (size_t)r * 4096 + c); f32x4 o;
                        o[0] = v[0] * __uint_as_float(gw.x << 16); o[1] = v[1] * __uint_as_float(gw.x & 0xffff0000u); o[2] = v[2] * __uint_as_float(gw.y << 16); o[3] = v[3] * __uint_as_float(gw.y & 0xffff0000u);
                        if (u.pm == 32) *(f32x4*)(part + ((size_t)(u.k0 >> 2) * MS + (r - MP)) * D + c) = o; else *(f32x4*)(T1 + (size_t)r * D + c) = o; } }
    }
};
struct EpiGateB {
    float* T1; const bf16_t* GT; bf16_t* MIX; float* part;
    __device__ __forceinline__ void operator()(const f32x4 (&acc)[2][2][4][2], const Unit& u, int wr, int wc, int fr, int fq) const {
#pragma unroll
        for (int ai = 0; ai < 2; ++ai)
#pragma unroll
            for (int m = 0; m < 4; ++m) { const int r = EPI_ROW(ai, m);
#pragma unroll
                for (int bj = 0; bj < 2; ++bj)
#pragma unroll
                    for (int n = 0; n < 2; ++n) { const int c = EPI_COL(bj, n); const f32x4 v = acc[ai][bj][m][n];
                        const u32x2 gw = *(const u32x2*)(GT + (size_t)r * 4096 + 2048 + c); f32x4 o;
                        if (u.pm == 32) { o[0] = v[0] * __uint_as_float(gw.x << 16); o[1] = v[1] * __uint_as_float(gw.x & 0xffff0000u); o[2] = v[2] * __uint_as_float(gw.y << 16); o[3] = v[3] * __uint_as_float(gw.y & 0xffff0000u);
                            *(f32x4*)(part + ((size_t)(u.k0 >> 2) * MS + (r - MP)) * D + c) = o; continue; }
                        const f32x4 t1 = *(const f32x4*)(T1 + (size_t)r * D + c);
                        o[0] = t1[0] + v[0] * __uint_as_float(gw.x << 16); o[1] = t1[1] + v[1] * __uint_as_float(gw.x & 0xffff0000u);
                        o[2] = t1[2] + v[2] * __uint_as_float(gw.y << 16); o[3] = t1[3] + v[3] * __uint_as_float(gw.y & 0xffff0000u);
                        u32x2 w; w.x = pk2(o[0], o[1]); w.y = pk2(o[2], o[3]); *(u32x2*)(MIX + (size_t)r * D + c) = w; } }
    }
};

struct TrJob { const float* W; bf16_t* WT; int K, N, item; int sw; };
__device__ __forceinline__ void tr_load(const TrJob& jb, int lane, float (&tv)[32]) {
    const int nblk = jb.N / 32, kb = jb.item / nblk, nb = jb.item - kb * nblk, k0 = 64 * kb, n0 = 32 * nb;
#pragma unroll
    for (int i = 0; i < 32; ++i) tv[i] = __builtin_nontemporal_load(jb.W + (size_t)(k0 + 2 * i + (lane >> 5)) * jb.N + n0 + (lane & 31));
}
__device__ __forceinline__ void tr_store(const TrJob& jb, int lane, const float (&tv)[32], LAS float* scr) {
    const int nblk = jb.N / 32, kb = jb.item / nblk, nb = jb.item - kb * nblk, k0 = 64 * kb, n0 = 32 * nb;
#pragma unroll
    for (int i = 0; i < 32; ++i) scr[(2 * i + (lane >> 5)) * 33 + (lane & 31)] = tv[i];
    LDS_WAIT();
    int d0 = n0;
    if (jb.sw) { const int bj = n0 / FF, j = n0 - bj * FF; d0 = 256 * (j >> 7) + 128 * bj + (j & 127); }
    const int c = lane & 7;
#pragma unroll
    for (int j = 0; j < 4; ++j) { const int n = (lane >> 3) + 8 * j; const LAS float* sp = scr + (8 * c) * 33 + n;
        u32x4 o; o.x = pk2(sp[0 * 33], sp[1 * 33]); o.y = pk2(sp[2 * 33], sp[3 * 33]); o.z = pk2(sp[4 * 33], sp[5 * 33]); o.w = pk2(sp[6 * 33], sp[7 * 33]);
        *(u32x4*)(jb.WT + (size_t)(d0 + n) * jb.K + k0 + 8 * c) = o; }
    LDS_WAIT();
}
#define TR_RUN(first, count, stride, RESOLVE) do { int it_ = (first); if (it_ < (count)) { TrJob ja_, jb_; float ta_[32], tb_[32]; RESOLVE(it_, ja_); tr_load(ja_, lane, ta_); \
        for (;;) { int nx_ = it_ + (stride); if (nx_ < (count)) { RESOLVE(nx_, jb_); tr_load(jb_, lane, tb_); } tr_store(ja_, lane, ta_, TR_SCR); if (nx_ >= (count)) break; it_ = nx_; \
                   nx_ = it_ + (stride); if (nx_ < (count)) { RESOLVE(nx_, ja_); tr_load(ja_, lane, ta_); } tr_store(jb_, lane, tb_, TR_SCR); if (nx_ >= (count)) break; it_ = nx_; } } } while (0)

__device__ __forceinline__ void resnorm_load(const float* xin, const float* Y, int lane, f32x4 (&y)[8], f32x4 (&x)[8]) {
#pragma unroll
    for (int j = 0; j < 8; ++j) { y[j] = ((const f32x4*)Y)[lane + 64 * j]; x[j] = ((const f32x4*)xin)[lane + 64 * j]; }
}
__device__ __forceinline__ void resnorm_proc(f32x4 (&y)[8], const f32x4 (&x)[8], float scale, const float* gpost, const float* gnext, float* xout, bf16_t* hout, int lane) {
    float s = 0.f;
#pragma unroll
    for (int j = 0; j < 8; ++j) s += (y[j][0] * y[j][0] + y[j][1] * y[j][1]) + (y[j][2] * y[j][2] + y[j][3] * y[j][3]);
    const float rs = scale * rsqrtf(wave_sum(s) * (1.f / D) + RMS_EPS);
    float s2 = 0.f;
#pragma unroll
    for (int j = 0; j < 8; ++j) { const f32x4 g = ((const f32x4*)gpost)[lane + 64 * j];
        y[j] = x[j] + y[j] * g * rs; ((f32x4*)xout)[lane + 64 * j] = y[j];
        s2 += (y[j][0] * y[j][0] + y[j][1] * y[j][1]) + (y[j][2] * y[j][2] + y[j][3] * y[j][3]); }
    if (hout) { const float rs2 = rsqrtf(wave_sum(s2) * (1.f / D) + RMS_EPS);
#pragma unroll
        for (int j = 0; j < 8; ++j) { const f32x4 g = ((const f32x4*)gnext)[lane + 64 * j]; u32x2 w; w.x = pk2(y[j][0] * rs2 * g[0], y[j][1] * rs2 * g[1]); w.y = pk2(y[j][2] * rs2 * g[2], y[j][3] * rs2 * g[3]);
            ((u32x2*)hout)[lane + 64 * j] = w; } }
}
#define RESNORM_ROWS(XIN, SCALE, GPOST, GNEXT, HOUT) do { int r_ = gw; if (r_ < MP) { f32x4 ya_[8], xa_[8], yb_[8], xb_[8]; resnorm_load((XIN) + (size_t)r_ * D, Y + (size_t)r_ * D, lane, ya_, xa_); \
        for (;;) { int n_ = r_ + NGW; if (n_ < MP) resnorm_load((XIN) + (size_t)n_ * D, Y + (size_t)n_ * D, lane, yb_, xb_); \
                   resnorm_proc(ya_, xa_, (SCALE), (GPOST), (GNEXT), X1 + (size_t)r_ * D, (HOUT) ? (HOUT) + (size_t)r_ * D : nullptr, lane); if (n_ >= MP) break; r_ = n_; \
                   n_ = r_ + NGW; if (n_ < MP) resnorm_load((XIN) + (size_t)n_ * D, Y + (size_t)n_ * D, lane, ya_, xa_); \
                   resnorm_proc(yb_, xb_, (SCALE), (GPOST), (GNEXT), X1 + (size_t)r_ * D, (HOUT) ? (HOUT) + (size_t)r_ * D : nullptr, lane); if (n_ >= MP) break; r_ = n_; } } } while (0)

__device__ __forceinline__ float block_sum(float v, LAS float* red, int wave) {
    v = wave_sum(v); __syncthreads(); if ((threadIdx.x & 63) == 0) red[wave] = v; __syncthreads();
    return ((red[0] + red[1]) + (red[2] + red[3])) + ((red[4] + red[5]) + (red[6] + red[7]));
}
__device__ __forceinline__ void resnorm_row_block(const float* xin, const float* P0, int nparts, float scale, const float* gpost, const float* gnext, float* xout, bf16_t* hout, LAS float* red, int wave) {
    const int t = threadIdx.x; f32x4 y = (f32x4){0.f, 0.f, 0.f, 0.f};
#pragma unroll 11
    for (int q = 0; q < nparts; ++q) y += ((const f32x4*)(P0 + (size_t)q * MS * D))[t];
    const float rs = scale * rsqrtf(block_sum((y[0] * y[0] + y[1] * y[1]) + (y[2] * y[2] + y[3] * y[3]), red, wave) * (1.f / D) + RMS_EPS);
    const f32x4 x = ((const f32x4*)xin)[t], g = ((const f32x4*)gpost)[t];
    y = x + y * g * rs; ((f32x4*)xout)[t] = y;
    if (hout) { const float rs2 = rsqrtf(block_sum((y[0] * y[0] + y[1] * y[1]) + (y[2] * y[2] + y[3] * y[3]), red, wave) * (1.f / D) + RMS_EPS);
        const f32x4 gn = ((const f32x4*)gnext)[t]; u32x2 w; w.x = pk2(y[0] * rs2 * gn[0], y[1] * rs2 * gn[1]); w.y = pk2(y[2] * rs2 * gn[2], y[3] * rs2 * gn[3]); ((u32x2*)hout)[t] = w; }
}

__device__ __forceinline__ void attn_unit(const bf16_t* Qp, const bf16_t* Kp, const bf16_t* Vt, int vstride, int key_lo, int ntiles, int key_hi, int q_abs0,
                                          const LAS float* bias, bf16_t* Op, int lane) {
    const int fr = lane & 15, fq = lane >> 4;
    bf16x8 qf[2];
#pragma unroll
    for (int ks = 0; ks < 2; ++ks) qf[ks] = *(const bf16x8*)(Qp + (size_t)fr * HW + fq * 8 + 32 * ks);
    float m_run = -1e30f, l_run = 0.f;
    f32x4 o[4];
#pragma unroll
    for (int db = 0; db < 4; ++db) o[db] = (f32x4){0.f, 0.f, 0.f, 0.f};
    const int qa = q_abs0 + fr;
#define ATT_LOAD(KF, VLO, VHI, K0) do { \
        _Pragma("unroll") for (int nb = 0; nb < 4; ++nb) _Pragma("unroll") for (int ks = 0; ks < 2; ++ks) KF[nb][ks] = *(const bf16x8*)(Kp + (size_t)((K0) + 16 * nb + fr) * HW + fq * 8 + 32 * ks); \
        _Pragma("unroll") for (int db = 0; db < 4; ++db) _Pragma("unroll") for (int ks = 0; ks < 2; ++ks) { const bf16_t* vp = Vt + (size_t)(16 * db + fr) * vstride + (K0) + 32 * ks + 4 * fq; \
            VLO[db][ks] = *(const u32x2*)vp; VHI[db][ks] = *(const u32x2*)(vp + 16); } } while (0)
    bf16x8 kf[4][2]; u32x2 vlo[4][2], vhi[4][2];
    ATT_LOAD(kf, vlo, vhi, key_lo);
#pragma unroll 1
    for (int tile = 0; tile < ntiles; ++tile) {
        const int key0 = key_lo + 64 * tile;
        const int keyn = key0 + (tile + 1 < ntiles ? 64 : 0);
        bf16x8 kfn[4][2]; u32x2 vlon[4][2], vhin[4][2];
        ATT_LOAD(kfn, vlon, vhin, keyn);
        f32x4 s[4];
#pragma unroll
        for (int nb = 0; nb < 4; ++nb) { s[nb] = (f32x4){0.f, 0.f, 0.f, 0.f};
#pragma unroll
            for (int ks = 0; ks < 2; ++ks) s[nb] = __builtin_amdgcn_mfma_f32_16x16x32_bf16(kf[nb][ks], qf[ks], s[nb], 0, 0, 0); }
        float mx = -1e30f;
        if (q_abs0 - (key0 + 63) >= 128 && key0 + 64 <= key_hi) {
            const float bfar = bias[256];
#pragma unroll
            for (int nb = 0; nb < 4; ++nb)
#pragma unroll
                for (int j = 0; j < 4; ++j) { const float v = s[nb][j] + bfar; s[nb][j] = v; mx = fmaxf(mx, v); }
        } else {
#pragma unroll
            for (int nb = 0; nb < 4; ++nb)
#pragma unroll
                for (int j = 0; j < 4; ++j) { const int key = key0 + 16 * nb + 4 * fq + j; int rel = qa - key; rel = rel < -128 ? -128 : (rel > 128 ? 128 : rel);
                    float v = s[nb][j] + bias[rel + 128]; v = key < key_hi ? v : -1e30f; s[nb][j] = v; mx = fmaxf(mx, v); }
        }
        mx = fmaxf(mx, __shfl_xor(mx, 16)); mx = fmaxf(mx, __shfl_xor(mx, 32));
        const float m_new = fmaxf(m_run, mx), alpha = __expf(m_run - m_new);
        float ps = 0.f;
#pragma unroll
        for (int nb = 0; nb < 4; ++nb)
#pragma unroll
            for (int j = 0; j < 4; ++j) { const float p = __expf(s[nb][j] - m_new); s[nb][j] = p; ps += p; }
        l_run = l_run * alpha + ps; m_run = m_new;
#pragma unroll
        for (int db = 0; db < 4; ++db) o[db] *= alpha;
#pragma unroll
        for (int ks = 0; ks < 2; ++ks) { u32x4 pw; pw.x = pk2(s[2 * ks][0], s[2 * ks][1]); pw.y = pk2(s[2 * ks][2], s[2 * ks][3]); pw.z = pk2(s[2 * ks + 1][0], s[2 * ks + 1][1]); pw.w = pk2(s[2 * ks + 1][2], s[2 * ks + 1][3]);
            const bf16x8 pf = __builtin_bit_cast(bf16x8, pw);
#pragma unroll
            for (int db = 0; db < 4; ++db) { u32x4 vw; vw.x = vlo[db][ks].x; vw.y = vlo[db][ks].y; vw.z = vhi[db][ks].x; vw.w = vhi[db][ks].y;
                o[db] = __builtin_amdgcn_mfma_f32_16x16x32_bf16(__builtin_bit_cast(bf16x8, vw), pf, o[db], 0, 0, 0); } }
#pragma unroll
        for (int a = 0; a < 4; ++a)
#pragma unroll
            for (int b = 0; b < 2; ++b) { kf[a][b] = kfn[a][b]; vlo[a][b] = vlon[a][b]; vhi[a][b] = vhin[a][b]; }
    }
#undef ATT_LOAD
    l_run += __shfl_xor(l_run, 16); l_run += __shfl_xor(l_run, 32);
    const float inv = 1.f / l_run;
#pragma unroll
    for (int db = 0; db < 4; ++db) { u32x2 w; w.x = pk2(o[db][0] * inv, o[db][1] * inv); w.y = pk2(o[db][2] * inv, o[db][3] * inv); *(u32x2*)(Op + (size_t)fr * HW + 16 * db + 4 * fq) = w; }
}

constexpr int TC = 32;
constexpr int CH_FLOATS = 6 * TC * 64;
__device__ __forceinline__ void scan_signal(LAS unsigned* cnt, int lane) {
    LDS_WAIT();
    if (lane == 0) __hip_atomic_fetch_add(cnt, 1u, __ATOMIC_RELAXED, __HIP_MEMORY_SCOPE_WORKGROUP);
}
__device__ __forceinline__ void scan_wait(LAS unsigned* cnt, unsigned target) {
    while (__hip_atomic_load(cnt, __ATOMIC_RELAXED, __HIP_MEMORY_SCOPE_WORKGROUP) < target) __builtin_amdgcn_s_sleep(1);
    asm volatile("" ::: "memory");
}
__device__ __forceinline__ void scan_unit4(LAS float* lds, LAS unsigned* cnt, unsigned& base, const float* R, const float* Kk, const float* V, const float* Wd, const float* Aa,
                                           int row0, int T, int h, int quarter, const float* S0, float* Sout, float* Yraw, const float* k_k, const float* k_a) {
    const int tid = threadIdx.x, lane = tid & 63, wave = tid >> 6;
    const int ts = tid >> 4, f4 = tid & 15;
    const int rg = lane >> 4, j = lane & 15, row = quarter * 16 + wave * 4 + rg;
    const f32x4 kk4 = *(const f32x4*)(k_k + h * 64 + 4 * f4), ka4 = *(const f32x4*)(k_a + h * 64 + 4 * f4);
    f32x4 S = S0 ? *(const f32x4*)(S0 + row * 64 + 4 * j) : (f32x4){0.f, 0.f, 0.f, 0.f};
    const int nch = (T + TC - 1) / TC;
    f32x4 gr[2], gw[2], gk[2], gv[2], ga[2];
#define SCAN_LOAD(c) do { _Pragma("unroll") for (int q_ = 0; q_ < 2; ++q_) { const int t_ = (c) * TC + ts + 16 * q_; if (t_ < T) { const size_t o_ = (size_t)(row0 + t_) * HW + h * 64 + 4 * f4; \
        gr[q_] = *(const f32x4*)(R + o_); gw[q_] = *(const f32x4*)(Wd + o_); gk[q_] = *(const f32x4*)(Kk + o_); gv[q_] = *(const f32x4*)(V + o_); ga[q_] = *(const f32x4*)(Aa + o_); } \
        else { gr[q_] = gw[q_] = gk[q_] = gv[q_] = ga[q_] = (f32x4){0.f, 0.f, 0.f, 0.f}; } } } while (0)
#define SCAN_STORE(c) do { _Pragma("unroll") for (int q_ = 0; q_ < 2; ++q_) { LAS float* b_ = lds + ((c) & 1) * CH_FLOATS + (ts + 16 * q_) * 64 + 4 * f4; \
        const f32x4 kx = gk[q_] * kk4; float ss = (kx[0] * kx[0] + kx[1] * kx[1]) + (kx[2] * kx[2] + kx[3] * kx[3]); ss = row16_sum(ss); \
        const float inv = -__builtin_amdgcn_rsqf(fmaxf(ss, 1e-24f)); const f32x4 nkk = kx * inv; \
        *(LAS f32x4*)(b_) = gr[q_]; *(LAS f32x4*)(b_ + TC * 64) = gw[q_]; *(LAS f32x4*)(b_ + 2 * TC * 64) = gk[q_] * (1.f + (ga[q_] - 1.f) * ka4); \
        *(LAS f32x4*)(b_ + 3 * TC * 64) = nkk; *(LAS f32x4*)(b_ + 4 * TC * 64) = -nkk * ga[q_]; \
        LAS float* v_ = lds + ((c) & 1) * CH_FLOATS + 5 * TC * 64 + (4 * f4) * TC + ts + 16 * q_; v_[0] = gv[q_][0]; v_[TC] = gv[q_][1]; v_[2 * TC] = gv[q_][2]; v_[3 * TC] = gv[q_][3]; } } while (0)
    SCAN_LOAD(0); SCAN_STORE(0); scan_signal(cnt, lane);
    for (int c = 0; c < nch; ++c) {
        if (c + 1 < nch) SCAN_LOAD(c + 1);
        scan_wait(cnt, 4u * (base + (unsigned)c + 1u));
        const LAS float* buf = lds + (c & 1) * CH_FLOATS;
        const int nst = (T - c * TC) < TC ? (T - c * TC) : TC;
        const LAS float* bt = buf + 4 * j; const LAS float* bv = buf + 5 * TC * 64 + row * TC;
        f32x4 r4 = *(const LAS f32x4*)(bt), w4 = *(const LAS f32x4*)(bt + TC * 64), kp4 = *(const LAS f32x4*)(bt + 2 * TC * 64),
              nk4 = *(const LAS f32x4*)(bt + 3 * TC * 64), ka_4 = *(const LAS f32x4*)(bt + 4 * TC * 64);
        f32x4 r4b = *(const LAS f32x4*)(bt + 64), w4b = *(const LAS f32x4*)(bt + 64 + TC * 64), kp4b = *(const LAS f32x4*)(bt + 64 + 2 * TC * 64),
              nk4b = *(const LAS f32x4*)(bt + 64 + 3 * TC * 64), ka_4b = *(const LAS f32x4*)(bt + 64 + 4 * TC * 64);
        for (int t0 = 0; t0 < nst; t0 += 16) {
            float vv16[16];
#pragma unroll
            for (int i = 0; i < 4; ++i) { const f32x4 t_ = *(const LAS f32x4*)(bv + t0 + 4 * i); vv16[4 * i] = t_[0]; vv16[4 * i + 1] = t_[1]; vv16[4 * i + 2] = t_[2]; vv16[4 * i + 3] = t_[3]; }
            float yp[16];
            f32x4 rprev = r4;
#pragma unroll
            for (int tt = 0; tt < 16; ++tt) {
                const LAS float* bn = bt + (t0 + tt + 2) * 64;
                const f32x4 r4n = *(const LAS f32x4*)(bn), w4n = *(const LAS f32x4*)(bn + TC * 64), kp4n = *(const LAS f32x4*)(bn + 2 * TC * 64),
                            nk4n = *(const LAS f32x4*)(bn + 3 * TC * 64), ka_4n = *(const LAS f32x4*)(bn + 4 * TC * 64);
                f32x2 d2 = (f32x2){S[0], S[1]} * (f32x2){nk4[0], nk4[1]};
                f32x2 e2 = (f32x2){S[0], S[1]} * (f32x2){rprev[0], rprev[1]};
                d2 = __builtin_elementwise_fma((f32x2){S[2], S[3]}, (f32x2){nk4[2], nk4[3]}, d2);
                e2 = __builtin_elementwise_fma((f32x2){S[2], S[3]}, (f32x2){rprev[2], rprev[3]}, e2);
                float sa = d2[0] + d2[1];
                if (tt > 0) yp[tt - 1] = e2[0] + e2[1];
                sa = row16_sum(sa);
                S = S * w4 + ka_4 * sa + kp4 * vv16[tt];
                rprev = r4;
                r4 = r4b; w4 = w4b; kp4 = kp4b; nk4 = nk4b; ka_4 = ka_4b;
                r4b = r4n; w4b = w4n; kp4b = kp4n; nk4b = nk4n; ka_4b = ka_4n;
            }
            { f32x2 e2 = (f32x2){S[0], S[1]} * (f32x2){rprev[0], rprev[1]}; e2 = __builtin_elementwise_fma((f32x2){S[2], S[3]}, (f32x2){rprev[2], rprev[3]}, e2); yp[15] = e2[0] + e2[1]; }
            float ykeep;
            { const bool b3 = (j & 8) != 0, b2 = (j & 4) != 0, b1 = (j & 2) != 0, b0 = (j & 1) != 0;
#define DPP_GET(v, ctrl) __builtin_bit_cast(float, __builtin_amdgcn_update_dpp(0, __builtin_bit_cast(int, (v)), (ctrl), 0xf, 0xf, true))
              float q8[8], q4[4], q2[2];
#pragma unroll
              for (int i = 0; i < 8; ++i) { const float keep = b3 ? yp[8 + i] : yp[i], send = b3 ? yp[i] : yp[8 + i]; q8[i] = keep + DPP_GET(send, 0x128); }
#pragma unroll
              for (int i = 0; i < 4; ++i) { const float keep = b2 ? q8[4 + i] : q8[i], send = b2 ? q8[i] : q8[4 + i]; q4[i] = keep + DPP_GET(send, 0x141); }
#pragma unroll
              for (int i = 0; i < 2; ++i) { const float keep = b1 ? q4[2 + i] : q4[i], send = b1 ? q4[i] : q4[2 + i]; q2[i] = keep + DPP_GET(send, 0x4E); }
              { const float keep = b0 ? q2[1] : q2[0], send = b0 ? q2[0] : q2[1]; ykeep = keep + DPP_GET(send, 0xB1); }
#undef DPP_GET
            }
            Yraw[(size_t)(row0 + c * TC + t0 + j) * HW + h * 64 + row] = ykeep;
        }
        if (c + 1 < nch) { SCAN_STORE(c + 1); scan_signal(cnt, lane); }
    }
    scan_signal(cnt, lane); scan_wait(cnt, 4u * (base + (unsigned)nch + 1u)); base += (unsigned)nch + 1u;
    *(f32x4*)(Sout + row * 64 + 4 * j) = S;
#undef SCAN_LOAD
#undef SCAN_STORE
}

__global__ void __launch_bounds__(512, 2) mega(Params p) {
    extern __shared__ __attribute__((aligned(16))) unsigned char smem[];
    LAS unsigned char* lds = (LAS unsigned char*)smem;
    cg::grid_group grid = cg::this_grid();
    const int tid = threadIdx.x, lane = tid & 63, wave = __builtin_amdgcn_readfirstlane(tid >> 6);
    const int G = gridDim.x, bx = blockIdx.x, gw = bx * 8 + wave, NGW = G * 8;
    unsigned char* ws = p.ws; float* out = p.out;
    const float* x_p = p.in[0]; const float* x_s = p.in[1];
    bf16_t* WA = (bf16_t*)(ws + WS_WA); bf16_t* WB = (bf16_t*)(ws + WS_WB); bf16_t* WATT = (bf16_t*)(ws + WS_WATT); bf16_t* WRW = (bf16_t*)(ws + WS_WRW);
    bf16_t* WOUT = (bf16_t*)(ws + WS_WOUT); bf16_t* WL = (bf16_t*)(ws + WS_WL); bf16_t* LIN = (bf16_t*)(ws + WS_WB);
    bf16_t* H = (bf16_t*)(ws + WS_E); bf16_t* ATTO = (bf16_t*)(ws + WS_E); bf16_t* RWY = (bf16_t*)(ws + WS_E + SZ_Q);
    bf16_t* ACT = (bf16_t*)(ws + WS_FG); float* Y = (float*)(ws + WS_Y); float* PB = (float*)(ws + WS_PB);
    bf16_t* QB = (bf16_t*)(ws + WS_QB); bf16_t* KB = (bf16_t*)(ws + WS_KB);
    float* WD = (float*)(ws + WS_W); float* AA = (float*)(ws + WS_A); bf16_t* GG = (bf16_t*)(ws + WS_G); float* YR = (float*)(ws + WS_YR);
    bf16_t* VT = (bf16_t*)(ws + WS_VT); bf16_t* KC = (bf16_t*)(ws + WS_KC); bf16_t* VS = (bf16_t*)(ws + WS_VS);
    float* PART = (float*)(ws + WS_RKV + 48 * 1024 * 1024);
    float* RKV = (float*)(ws + WS_RKV); bf16_t* MIX = (bf16_t*)(ws + WS_RKV); bf16_t* GT = (bf16_t*)(ws + WS_GT);
    float* X1 = out + O_Y;
    LAS float* scr = (LAS float*)(lds + wave * 8448);
    const int lo = p.ph_lo, hi = p.ph_hi;
#define IN(k) (lo <= (k) && (k) < hi)
#define SEAM(k) do { if (IN(k) && IN((k) + 1)) { if ((k) == 0) { grid.sync(); xbar = xcd_barrier_post(barw, xst); } else xcd_barrier(xbar); } } while (0)
    pg8::StaticOrder S; pg8::SplitOrder SS;
    unsigned* barw = (unsigned*)(ws + WS_BAR); volatile LAS unsigned* xst = (volatile LAS unsigned*)(lds + LDS_BYTES - 16);
    XcdBarrier xbar; xbar.bar = barw; xbar.x = 0; xbar.st = xst;
    if (tid < 4) xst[tid] = 0u;
    if (bx == 0) for (int i = tid; i < XCD_BAR_WORDS; i += 512) barw[i] = 0u;

    if (IN(0)) {
        constexpr int I_1 = 32 * 352, I_2 = 88 * 64, I_A = 16 * 64, I_O = 32 * 64;
#define TR_SCR scr
#define RES_P0(idx, jb) do { jb.W = p.in[8]; jb.WT = WA; jb.K = D; jb.N = 2 * FF; jb.item = (idx); jb.sw = 1; } while (0)
        TR_RUN(gw, I_1, NGW, RES_P0);
#undef TR_SCR
        for (int i = bx * 512 + tid; i < 64 * HW / 2; i += G * 512) ((unsigned*)(KC + (size_t)DB * KCAT * HW))[i] = 0u;
        for (int i = bx * 512 + tid; i < DB * 16 * 64 * 24; i += G * 512) { const int rr = i / 24, cc = i - rr * 24; ((unsigned*)(VS + (size_t)rr * VTS + KCAT))[cc] = 0u; }
        for (int r = gw; r < M; r += NGW) { const float* xr = r < MP ? x_p + (size_t)r * D : x_s + (size_t)(r - MP) * D;
            f32x4 v[8]; float s = 0.f;
#pragma unroll
            for (int j = 0; j < 8; ++j) { v[j] = ((const f32x4*)xr)[lane + 64 * j]; s += (v[j][0] * v[j][0] + v[j][1] * v[j][1]) + (v[j][2] * v[j][2] + v[j][3] * v[j][3]); }
            const float rs = rsqrtf(wave_sum(s) * (1.f / D) + RMS_EPS);
#pragma unroll
            for (int j = 0; j < 8; ++j) { const f32x4 g = ((const f32x4*)p.in[6])[lane + 64 * j]; u32x2 w; w.x = pk2(v[j][0] * rs * g[0], v[j][1] * rs * g[1]); w.y = pk2(v[j][2] * rs * g[2], v[j][3] * rs * g[3]);
                ((u32x2*)(H + (size_t)r * D))[lane + 64 * j] = w; } }
    }
    SEAM(0);
    if (IN(1)) { __syncthreads(); S.init(M, 2 * FF, G, bx, D); pg8::gemm_phase(lds, pg8::Gemm{H, WA, M, 2 * FF, D}, S, EpiSwiglu{ACT});
        const int nlast = (33 * 44) % G, nidle = (nlast ? G - nlast : G);
        if (bx >= G - nidle) { const int wi = (bx - (G - nidle)) * 8 + wave, nw = nidle * 8; constexpr int I_2 = 88 * 64;
#define TR_SCR scr
#define RES_P1(idx, jb) do { jb.W = p.in[9]; jb.WT = WB; jb.K = FF; jb.N = D; jb.item = (idx); jb.sw = 0; } while (0)
            TR_RUN(wi, I_2, nw, RES_P1);
#undef TR_SCR
            { const int ci = bx - (G - nidle);
        for (int i0 = ci * 512 + tid; i0 < 3072 * 512; i0 += 4 * nidle * 512) { float v4[4];
#pragma unroll
            for (int u = 0; u < 4; ++u) { const int i = i0 + u * nidle * 512; float v = 0.f; if (i < 3072 * 512) { const int n = i >> 9, k = i & 511, sec = n >> 10, c = n & 1023;
                if (sec == 0) { if (k < 96) v = p.in[17][k * HW + c]; } else if (sec == 1) { if (k >= 96 && k < 192) v = p.in[19][(k - 96) * HW + c]; } else { if (k >= 192 && k < 448) v = p.in[20][(k - 192) * HW + c]; } } v4[u] = v; }
#pragma unroll
            for (int u = 0; u < 4; ++u) { const int i = i0 + u * nidle * 512; if (i < 3072 * 512) WL[i] = (bf16_t)(pk2(v4[u], 0.f) & 0xffffu); } }
            }
        } }
    SEAM(1);
    if (IN(2)) { SS.init(M, D, G, bx, FF); pg8::gemm_phase(lds, pg8::Gemm{ACT, WB, M, D, FF}, SS, EpiF32{Y, D, PART}); }
    SEAM(2);
    if (IN(3)) {
        for (int i = bx; i < MS; i += G) resnorm_row_block(x_s + (size_t)i * D, PART + (size_t)i * D, FF / 256, 0.5f, p.in[7], p.in[10], X1 + (size_t)(MP + i) * D, H + (size_t)(MP + i) * D, (LAS float*)lds, wave);
        RESNORM_ROWS(x_p, 0.5f, p.in[7], p.in[10], H);
        __syncthreads();
#define TR_SCR scr
#define RES_P3(idx, jb) do { jb.W = p.in[12]; jb.WT = WA; jb.K = D; jb.N = NIN; jb.item = (idx); jb.sw = 0; } while (0)
        TR_RUN(gw, 32 * (NIN / 32), NGW, RES_P3);
#undef TR_SCR
        for (int i = bx * 512 + tid; i < (NINP - NIN) * D / 2; i += G * 512) ((unsigned*)(WA + (size_t)NIN * D))[i] = 0u;
    }
    SEAM(3);
    if (IN(4)) { __syncthreads(); S.init(M, NINP, G, bx, D); pg8::gemm_phase(lds, pg8::Gemm{H, WA, M, NINP, D}, S, EpiWin{QB, KB, KC, VT, VS, GT, PB, out});
        const int nlast = (33 * 42) % G, nidle = (nlast ? G - nlast : G);
        if (bx >= G - nidle) { const int ci = bx - (G - nidle);
        for (int i0 = ci * 512 + tid; i0 < DB * NPAST * (HW / 4); i0 += 4 * nidle * 512) { f32x4 v4[4];
#pragma unroll
            for (int u = 0; u < 4; ++u) { const int i = i0 + u * nidle * 512; if (i < DB * NPAST * (HW / 4)) v4[u] = __builtin_nontemporal_load((const f32x4*)p.in[2] + i); }
#pragma unroll
            for (int u = 0; u < 4; ++u) { const int i = i0 + u * nidle * 512; if (i < DB * NPAST * (HW / 4)) { const int c4 = i & 255, rj = i >> 8, b = rj >> 9, jj = rj & 511; const f32x4 v = v4[u];
                u32x2 w; w.x = pk2(v[0], v[1]); w.y = pk2(v[2], v[3]); *(u32x2*)(KC + ((size_t)b * KCAT + jj) * HW + 4 * c4) = w; } } }
        for (int i0 = ci * 512 + tid; i0 < DB * 16 * 64 * 64; i0 += 2 * nidle * 512) { float t16[2][8];
#pragma unroll
            for (int u = 0; u < 2; ++u) { const int i = i0 + u * nidle * 512; if (i < DB * 16 * 64 * 64) { const int d = i & 63, jg = (i >> 6) & 63, hh = (i >> 12) & 15, b = i >> 16;
                const float* src = p.in[3] + ((size_t)b * NPAST + jg * 8) * HW + hh * 64 + d;
#pragma unroll
                for (int e = 0; e < 8; ++e) t16[u][e] = __builtin_nontemporal_load(src + e * HW); } }
#pragma unroll
            for (int u = 0; u < 2; ++u) { const int i = i0 + u * nidle * 512; if (i < DB * 16 * 64 * 64) { const int d = i & 63, jg = (i >> 6) & 63, hh = (i >> 12) & 15, b = i >> 16; u32x4 w;
                w.x = pk2(t16[u][0], t16[u][1]); w.y = pk2(t16[u][2], t16[u][3]); w.z = pk2(t16[u][4], t16[u][5]); w.w = pk2(t16[u][6], t16[u][7]);
                *(u32x4*)(VS + ((size_t)(b * 16 + hh) * 64 + d) * VTS + jg * 8) = w; } } }
            { const int wi = ci * 8 + wave, nw = nidle * 8; constexpr int I_A = 16 * 64, I_O = 32 * 64;
#define TR_SCR scr
#define RES_P4(idx, jb) do { int r_ = (idx); \
                if (r_ < I_A) { jb.W = p.in[14]; jb.WT = WATT; jb.K = HW; jb.N = D; jb.item = r_; jb.sw = 0; } \
                else if ((r_ -= I_A) < I_A) { jb.W = p.in[26]; jb.WT = WRW; jb.K = HW; jb.N = D; jb.item = r_; jb.sw = 0; } \
                else { r_ -= I_A; jb.W = p.in[27]; jb.WT = WOUT; jb.K = D; jb.N = D; jb.item = r_; jb.sw = 0; } } while (0)
              TR_RUN(wi, 2 * I_A + I_O, nw, RES_P4);
#undef TR_SCR
            }
        } }
    SEAM(4);
    if (IN(5)) {
        const float* mu = p.in[15];
        for (int r = gw; r < M; r += NGW) {
            const bool smp = r >= MP; const int b = smp ? ((r - MP) >> 4) : (r >> 11), t = smp ? ((r - MP) & 15) : (r & 2047);
            const float* pr = PB + (size_t)r * SW; const float* pv = t > 0 ? pr - SW : (smp ? p.in[5] + (size_t)b * SW : nullptr);
            float* so = nullptr; if (smp) { if (t == DT - 1) so = out + O_SHS + (size_t)b * SW; } else { if (t == SEQ - 1) so = out + O_SHP + (size_t)b * SW; }
            for (int ch0 = lane; ch0 < SW / 4; ch0 += 64 * 7) {
                f32x4 av[7], qv[7], mv[7];
#pragma unroll
                for (int u = 0; u < 7; ++u) { const int ch = ch0 + 64 * u; if (ch < SW / 4) { av[u] = ((const f32x4*)pr)[ch]; qv[u] = pv ? ((const f32x4*)pv)[ch] : (f32x4){0.f, 0.f, 0.f, 0.f}; mv[u] = ((const f32x4*)mu)[ch]; } }
#pragma unroll
                for (int u = 0; u < 7; ++u) { const int ch = ch0 + 64 * u; if (ch < SW / 4) { const int c = ch * 4; const f32x4 a = av[u]; const f32x4 xm = a + (qv[u] - a) * mv[u];
                if (so) ((f32x4*)so)[ch] = a;
                if (c < 3072) { *(f32x4*)(RKV + (size_t)(c >> 10) * M * HW + (size_t)r * HW + (c & 1023)) = xm; }
                else { float o[4]; int dc;
                    if (c < 3168) { dc = c - 3072;
#pragma unroll
                        for (int i = 0; i < 4; ++i) { const float e = __expf(2.f * xm[i]); o[i] = 1.f - 2.f / (e + 1.f); } }
                    else if (c < 3264) { dc = 96 + c - 3168;
#pragma unroll
                        for (int i = 0; i < 4; ++i) o[i] = xm[i]; }
                    else { dc = 192 + c - 3264;
#pragma unroll
                        for (int i = 0; i < 4; ++i) o[i] = sigmoidf_(xm[i]); }
                    u32x2 w; w.x = pk2(o[0], o[1]); w.y = pk2(o[2], o[3]); *(u32x2*)(LIN + (size_t)r * 512 + dc) = w; } } }
            }
            if (lane < 32) ((unsigned*)(LIN + (size_t)r * 512 + 448))[lane] = 0u;
        }
    }
    SEAM(5);
    if (IN(6)) { __syncthreads(); S.init(M, 3072, G, bx, 512); pg8::gemm_phase(lds, pg8::Gemm{LIN, WL, M, 3072, 512}, S, EpiLora{WD, AA, GG, p.in[16], p.in[18]}); }
    SEAM(6);
    if (IN(7)) {
        LAS float* biasT = (LAS float*)(lds + 2 * CH_FLOATS * 4);
        LAS unsigned* cnt = (LAS unsigned*)(lds + 2 * CH_FLOATS * 4 + 16 * 257 * 4);
        for (int i = tid; i < 16 * 257; i += 512) biasT[i] = p.in[13][i];
        if (tid == 0) *cnt = 0u;
        __syncthreads();
        const float* Rr = RKV; const float* Kr = RKV + (size_t)M * HW; const float* Vr = RKV + 2 * (size_t)M * HW;
        if (wave < 4) {
            unsigned base = 0u;
            for (int un = bx; un < 1024; un += G) { const int chain = un >> 2, qt = un & 3, b = chain >> 4, h = chain & 15;
                scan_unit4((LAS float*)lds, cnt, base, Rr, Kr, Vr, WD, AA, MP + b * DT, DT, h, qt, p.in[4] + (size_t)chain * 4096, out + O_WKVS + (size_t)chain * 4096, YR, p.in[21], p.in[22]); }
            for (int un = bx; un < 256; un += G) { const int chain = un >> 2, qt = un & 3, b = chain >> 4, h = chain & 15;
                scan_unit4((LAS float*)lds, cnt, base, Rr, Kr, Vr, WD, AA, b * SEQ, SEQ, h, qt, nullptr, out + O_WKVP + (size_t)chain * 4096, YR, p.in[21], p.in[22]); }
        } else {
            const int w4 = bx * 4 + (wave - 4), NW4 = G * 4;
            for (int wu = w4; wu < 8192 + 256; wu += NW4) {
                if (wu < 8192) { const int qg = wu & 3, h = (wu >> 2) & 15, c = (wu >> 6) & 31, b = wu >> 11; const int m0 = b * SEQ + c * 64 + qg * 16;
                    const int klo = c >= 8 ? (c - 8) * 64 : 0, khi = (c + 1) * 64;
                    attn_unit(QB + (size_t)m0 * HW + h * 64, KB + (size_t)b * SEQ * HW + h * 64, VT + (size_t)(b * 16 + h) * 64 * SEQ, SEQ, klo, (khi - klo) >> 6, khi, c * 64 + qg * 16,
                              biasT + h * 257, ATTO + (size_t)m0 * HW + h * 64, lane); }
                else { const int sidx = wu - 8192, h = sidx & 15, b = sidx >> 4; const int m0 = MP + b * DT;
                    attn_unit(QB + (size_t)m0 * HW + h * 64, KC + (size_t)b * KCAT * HW + h * 64, VS + (size_t)(b * 16 + h) * 64 * VTS, VTS, 0, 9, KCAT, NPAST,
                              biasT + h * 257, ATTO + (size_t)m0 * HW + h * 64, lane); }
            }
            LAS float* scr7 = (LAS float*)(lds + 114816 + (wave - 4) * 8448);
            constexpr int I_1 = 32 * 352, I_2 = 88 * 64, I_A = 16 * 64, I_O = 32 * 64;
#define TR_SCR scr7
#define RES_P7(idx, jb) do { jb.W = p.in[30]; jb.WT = WA; jb.K = D; jb.N = 2 * FF; jb.item = (idx); jb.sw = 1; } while (0)
            TR_RUN(w4, I_1, NW4, RES_P7);
#undef TR_SCR
        }
    }
    SEAM(7);
    if (IN(8)) {
        const float* Rr = RKV; const float* Kr = RKV + (size_t)M * HW; const float* Vr = RKV + 2 * (size_t)M * HW;
        for (int r = gw; r < M; r += NGW) { const size_t o = (size_t)r * HW + lane * 16; const int c0 = lane * 16;
            f32x4 y[4], rr[4], kk[4], vv[4], aa[4];
#pragma unroll
            for (int i = 0; i < 4; ++i) { y[i] = *(const f32x4*)(YR + o + 4 * i); rr[i] = *(const f32x4*)(Rr + o + 4 * i); kk[i] = *(const f32x4*)(Kr + o + 4 * i); vv[i] = *(const f32x4*)(Vr + o + 4 * i); aa[i] = *(const f32x4*)(AA + o + 4 * i); }
            float s = 0.f, bn = 0.f;
#pragma unroll
            for (int i = 0; i < 4; ++i) { const f32x4 ka = *(const f32x4*)(p.in[22] + c0 + 4 * i), rk = *(const f32x4*)(p.in[23] + c0 + 4 * i);
#pragma unroll
                for (int e = 0; e < 4; ++e) { s += y[i][e]; bn += rr[i][e] * (kk[i][e] * (1.f + (aa[i][e] - 1.f) * ka[e])) * rk[e]; } }
            s += __shfl_xor(s, 1); s += __shfl_xor(s, 2); bn += __shfl_xor(bn, 1); bn += __shfl_xor(bn, 2);
            const float mean = s * (1.f / 64.f); float q = 0.f;
#pragma unroll
            for (int i = 0; i < 4; ++i)
#pragma unroll
                for (int e = 0; e < 4; ++e) { const float dlt = y[i][e] - mean; q += dlt * dlt; }
            q += __shfl_xor(q, 1); q += __shfl_xor(q, 2);
            const float rstd = rsqrtf(q * (1.f / 64.f) + GN_EPS);
            const u32x4 g0 = *(const u32x4*)(GG + o), g1 = *(const u32x4*)(GG + o + 8);
            const unsigned gws[8] = {g0.x, g0.y, g0.z, g0.w, g1.x, g1.y, g1.z, g1.w};
            unsigned ow[8];
#pragma unroll
            for (int i = 0; i < 4; ++i) { const f32x4 lw = *(const f32x4*)(p.in[24] + c0 + 4 * i), lb = *(const f32x4*)(p.in[25] + c0 + 4 * i); float ov[4];
#pragma unroll
                for (int e = 0; e < 4; ++e) { const unsigned gwd = gws[2 * i + (e >> 1)]; const float gf = (e & 1) ? __uint_as_float(gwd & 0xffff0000u) : __uint_as_float(gwd << 16);
                    ov[e] = ((y[i][e] - mean) * rstd * lw[e] + lb[e] + bn * vv[i][e]) * gf; }
                ow[2 * i] = pk2(ov[0], ov[1]); ow[2 * i + 1] = pk2(ov[2], ov[3]); }
            u32x4 w0; w0.x = ow[0]; w0.y = ow[1]; w0.z = ow[2]; w0.w = ow[3]; u32x4 w1; w1.x = ow[4]; w1.y = ow[5]; w1.z = ow[6]; w1.w = ow[7];
            *(u32x4*)(RWY + o) = w0; *(u32x4*)(RWY + o + 8) = w1; }
    }
    SEAM(8);
    if (IN(9)) { __syncthreads(); SS.init(M, D, G, bx, HW);
        pg8::gemm_phase(lds, pg8::Gemm{ATTO, WATT, M, D, HW}, SS, EpiGateA{Y, GT, PART});
        pg8::gemm_phase(lds, pg8::Gemm{RWY, WRW, M, D, HW}, SS, EpiGateB{Y, GT, MIX, PART + (size_t)4 * MS * D});
        xcd_barrier(xbar);
        for (int i = bx; i < MS; i += G) { f32x4 a = (f32x4){0.f, 0.f, 0.f, 0.f};
#pragma unroll
            for (int q = 0; q < 8; ++q) a += ((const f32x4*)(PART + ((size_t)q * MS + i) * D))[tid];
            u32x2 w; w.x = pk2(a[0], a[1]); w.y = pk2(a[2], a[3]); ((u32x2*)(MIX + (size_t)(MP + i) * D))[tid] = w; }
    }
    SEAM(9);
    if (IN(10)) { SS.init(M, D, G, bx, D); pg8::gemm_phase(lds, pg8::Gemm{MIX, WOUT, M, D, D}, SS, EpiF32{Y, D, PART}); }
    SEAM(10);
    if (IN(11)) {
        for (int i = bx; i < MS; i += G) resnorm_row_block(X1 + (size_t)(MP + i) * D, PART + (size_t)i * D, D / 256, 1.f, p.in[11], p.in[28], X1 + (size_t)(MP + i) * D, H + (size_t)(MP + i) * D, (LAS float*)lds, wave);
        RESNORM_ROWS(X1, 1.f, p.in[11], p.in[28], H); }
    SEAM(11);
    if (IN(12)) { __syncthreads(); S.init(M, 2 * FF, G, bx, D); pg8::gemm_phase(lds, pg8::Gemm{H, WA, M, 2 * FF, D}, S, EpiSwiglu{ACT});
        const int nlast = (33 * 44) % G, nidle = (nlast ? G - nlast : G);
        if (bx >= G - nidle) { const int wi = (bx - (G - nidle)) * 8 + wave, nw = nidle * 8; constexpr int I_2 = 88 * 64;
#define TR_SCR scr
#define RES_P12(idx, jb) do { jb.W = p.in[31]; jb.WT = WB; jb.K = FF; jb.N = D; jb.item = (idx); jb.sw = 0; } while (0)
            TR_RUN(wi, I_2, nw, RES_P12);
#undef TR_SCR
        } }
    SEAM(12);
    if (IN(13)) { SS.init(M, D, G, bx, FF); pg8::gemm_phase(lds, pg8::Gemm{ACT, WB, M, D, FF}, SS, EpiF32{Y, D, PART}); }
    SEAM(13);
    if (IN(14)) {
        for (int i = bx; i < MS; i += G) resnorm_row_block(X1 + (size_t)(MP + i) * D, PART + (size_t)i * D, FF / 256, 0.5f, p.in[29], nullptr, X1 + (size_t)(MP + i) * D, nullptr, (LAS float*)lds, wave);
        RESNORM_ROWS(X1, 0.5f, p.in[29], (const float*)nullptr, (bf16_t*)nullptr); }
}

extern "C" void kernel_launch(void* const* d_in, const int* in_sizes, int n_in, void* d_out, int out_size, void* d_ws, size_t ws_size, hipStream_t stream) {
    static int grid = 0;
    if (grid == 0) {
        if (n_in != 32 || ws_size < WS_END) { fprintf(stderr, "kernel_launch: unexpected n_in %d or workspace %zu < %zu\n", n_in, ws_size, (size_t)WS_END); grid = -1; return; }
        int dev = 0, cus = 0, per_cu = 0;
        hipGetDevice(&dev);
        hipDeviceGetAttribute(&cus, hipDeviceAttributeMultiprocessorCount, dev);
        if (hipFuncSetAttribute((const void*)mega, hipFuncAttributeMaxDynamicSharedMemorySize, LDS_BYTES) != hipSuccess) { fprintf(stderr, "kernel_launch: hipFuncSetAttribute failed\n"); grid = -1; return; }
        hipOccupancyMaxActiveBlocksPerMultiprocessor(&per_cu, (const void*)mega, 512, LDS_BYTES);
        (void)hipGetLastError();
        if (per_cu < 1) per_cu = 1;
        grid = cus * per_cu;
        if (grid > 256) grid = 256;
    }
    if (grid < 0) return;
    Params p{};
    for (int i = 0; i < 32; ++i) p.in[i] = (const float*)d_in[i];
    p.out = (float*)d_out; p.ws = (unsigned char*)d_ws; p.ph_lo = 0; p.ph_hi = 15;
    void* args[] = {&p};
    hipError_t e = hipLaunchCooperativeKernel((const void*)mega, dim3(grid), dim3(512), args, LDS_BYTES, stream);
    if (e != hipSuccess) fprintf(stderr, "cooperative launch failed: %s (grid %d)\n", hipGetErrorString(e), grid);
}
```
